# Optimizing an MI355X kernel written in HIP

```python
import jax, jax.numpy as jnp
from jax import lax
import numpy as np

D_MODEL = 2048
BATCH = 4
SEQ = 4096
DEPTH = 1

CHUNK = 64
N_LEFT_CHUNKS = 8
BAND = (N_LEFT_CHUNKS + 1) * CHUNK

ATT_WIDTH = D_MODEL // 2
ATT_HEADS = 8
ATT_HEAD_DIM = ATT_WIDTH // ATT_HEADS
MAX_REL = 128
REL_SIZE = 2 * MAX_REL + 1

GRN_WIDTH = D_MODEL - ATT_WIDTH
GRN_HEADS = 8
GRN_KEY_DIM = GRN_WIDTH // GRN_HEADS
GRN_VAL_DIM = GRN_WIDTH // GRN_HEADS

MIX_WIDTH = ATT_WIDTH + GRN_WIDTH
IN_COLS = 3 * ATT_WIDTH + 4 * GRN_WIDTH
D_FF = -(-8 * D_MODEL // (3 * 256)) * 256
EPS = 1e-6

kernel_name = "hybrid_chunk_attn_hgrn2_block"


def rmsnorm(x, gain):
    xf = x.astype(jnp.float32)
    y = xf * lax.rsqrt(jnp.mean(xf * xf, axis=-1, keepdims=True) + EPS)
    return (y * gain.astype(jnp.float32)).astype(x.dtype)


def chunk_band_attention(q, k, v, rel_bias):
    B, S, H, Dh = q.shape
    n_chunks = S // CHUNK
    qc = q.reshape(B, n_chunks, CHUNK, H, Dh)
    pad = ((0, 0), (N_LEFT_CHUNKS * CHUNK, 0), (0, 0), (0, 0))
    kp = jnp.pad(k, pad).reshape(B, n_chunks + N_LEFT_CHUNKS, CHUNK, H, Dh)
    vp = jnp.pad(v, pad).reshape(B, n_chunks + N_LEFT_CHUNKS, CHUNK, H, Dh)
    band_idx = jnp.arange(n_chunks)[:, None] + jnp.arange(N_LEFT_CHUNKS + 1)[None, :]
    kb = kp[:, band_idx].reshape(B, n_chunks, BAND, H, Dh)
    vb = vp[:, band_idx].reshape(B, n_chunks, BAND, H, Dh)
    scores = jnp.einsum('bcqhd,bckhd->bhcqk', qc, kb,
                        preferred_element_type=jnp.float32) * (Dh ** -0.5)
    dist = N_LEFT_CHUNKS * CHUNK + jnp.arange(CHUNK)[:, None] - jnp.arange(BAND)[None, :]
    rel_idx = jnp.clip(dist, -MAX_REL, MAX_REL) + MAX_REL
    bias = rel_bias.astype(jnp.float32)[:, rel_idx]
    scores = scores + bias[None, :, None]
    key_chunk = (jnp.arange(n_chunks)[:, None] - N_LEFT_CHUNKS
                 + jnp.arange(BAND)[None, :] // CHUNK)
    valid = key_chunk >= 0
    scores = jnp.where(valid[None, None, :, None, :], scores, jnp.finfo(jnp.float32).min)
    p = jax.nn.softmax(scores, axis=-1).astype(v.dtype)
    out = jnp.einsum('bhcqk,bckhd->bcqhd', p, vb)
    return out.reshape(B, S, H, Dh)


def hgrn2_mixer(q_raw, f_raw, i_val, g_raw, lb, gnorm_gain):
    B, S, _ = q_raw.shape
    n_chunks = S // CHUNK
    dtype = q_raw.dtype
    q = jax.nn.silu(q_raw.astype(jnp.float32))
    lbf = lb.astype(jnp.float32)
    f = lbf + (1.0 - lbf) * jax.nn.sigmoid(f_raw.astype(jnp.float32))
    k = 1.0 - f
    shp_k = (B, n_chunks, CHUNK, GRN_HEADS, GRN_KEY_DIM)
    q = q.reshape(shp_k)
    k = k.reshape(shp_k)
    b = jnp.cumsum(jnp.log(f).reshape(shp_k), axis=2)
    b_last = b[:, :, -1:]
    v = i_val.astype(jnp.float32).reshape(B, n_chunks, CHUNK, GRN_HEADS, GRN_VAL_DIM)
    q_dec = q * jnp.exp(b)
    a = jnp.einsum('bcthk,bcshk->bchts', q_dec, k * jnp.exp(-b))
    causal = jnp.tril(jnp.ones((CHUNK, CHUNK), dtype=bool))
    a = jnp.where(causal, a, 0.0)
    o_intra = jnp.einsum('bchts,bcshv->bcthv', a, v)
    u = jnp.einsum('bcshk,bcshv->bchkv', k * jnp.exp(b_last - b), v)
    decay = jnp.exp(b_last[:, :, 0])

    def step(state, inp):
        u_c, d_c = inp
        return d_c[..., None] * state + u_c, state

    s0 = jnp.zeros((B, GRN_HEADS, GRN_KEY_DIM, GRN_VAL_DIM), jnp.float32)
    _, s_start = lax.scan(step, s0, (jnp.swapaxes(u, 0, 1), jnp.swapaxes(decay, 0, 1)))
    s_start = jnp.swapaxes(s_start, 0, 1)
    o_inter = jnp.einsum('bcthk,bchkv->bcthv', q_dec, s_start)
    o = (o_intra + o_inter).reshape(B, S, GRN_HEADS, GRN_VAL_DIM)
    o = o * lax.rsqrt(jnp.mean(o * o, axis=-1, keepdims=True) + EPS) * gnorm_gain.astype(jnp.float32)
    o = o.reshape(B, S, GRN_HEADS * GRN_VAL_DIM) * jax.nn.silu(g_raw.astype(jnp.float32))
    return o.astype(dtype)


def setup_inputs(seed: int = 0) -> dict:
    key = jax.random.key(seed)
    ks = jax.random.split(key, 16)
    f32 = jnp.float32
    x = jax.random.normal(ks[0], (BATCH, SEQ, D_MODEL), f32)
    norm1_gain = 1.0 + 0.02 * jax.random.normal(ks[1], (DEPTH, D_MODEL), f32)
    w_in = jax.random.normal(ks[2], (DEPTH, D_MODEL, IN_COLS), f32) * D_MODEL ** -0.5
    rel_bias = 0.1 * jax.random.normal(ks[3], (DEPTH, ATT_HEADS, REL_SIZE), f32)
    lower_bounds = 0.1 * jax.random.normal(ks[4], (DEPTH + 1, GRN_WIDTH), f32)
    grn_norm_gain = 1.0 + 0.02 * jax.random.normal(ks[5], (DEPTH, GRN_VAL_DIM), f32)
    attn_out_gain = 1.0 + 0.02 * jax.random.normal(ks[6], (DEPTH, ATT_WIDTH), f32)
    w_out = jax.random.normal(ks[7], (DEPTH, MIX_WIDTH, D_MODEL), f32) * MIX_WIDTH ** -0.5
    norm2_gain = 1.0 + 0.02 * jax.random.normal(ks[8], (DEPTH, D_MODEL), f32)
    w_gate = jax.random.normal(ks[9], (DEPTH, D_MODEL, D_FF), f32) * D_MODEL ** -0.5
    w_up = jax.random.normal(ks[10], (DEPTH, D_MODEL, D_FF), f32) * D_MODEL ** -0.5
    w_down = jax.random.normal(ks[11], (DEPTH, D_FF, D_MODEL), f32) * D_FF ** -0.5
    final_gain = 1.0 + 0.02 * jax.random.normal(ks[12], (D_MODEL,), f32)
    return {"x": x, "norm1_gain": norm1_gain, "w_in": w_in, "rel_bias": rel_bias,
            "lower_bounds": lower_bounds, "grn_norm_gain": grn_norm_gain,
            "attn_out_gain": attn_out_gain, "w_out": w_out, "norm2_gain": norm2_gain,
            "w_gate": w_gate, "w_up": w_up, "w_down": w_down, "final_gain": final_gain}


def reference(x, norm1_gain, w_in, rel_bias, lower_bounds, grn_norm_gain, attn_out_gain,
              w_out, norm2_gain, w_gate, w_up, w_down, final_gain):
    B, S, _ = x.shape
    lb_all = jnp.cumsum(jax.nn.softmax(lower_bounds.astype(jnp.float32), axis=0), axis=0)
    for l in range(DEPTH):
        h = rmsnorm(x, norm1_gain[l])
        proj = h @ w_in[l]
        o1 = ATT_WIDTH
        q_a = proj[..., 0:o1].reshape(B, S, ATT_HEADS, ATT_HEAD_DIM)
        k_a = proj[..., o1:2 * o1].reshape(B, S, ATT_HEADS, ATT_HEAD_DIM)
        v_a = proj[..., 2 * o1:3 * o1].reshape(B, S, ATT_HEADS, ATT_HEAD_DIM)
        base = 3 * ATT_WIDTH
        q_r = proj[..., base:base + GRN_WIDTH]
        f_r = proj[..., base + GRN_WIDTH:base + 2 * GRN_WIDTH]
        i_r = proj[..., base + 2 * GRN_WIDTH:base + 3 * GRN_WIDTH]
        g_r = proj[..., base + 3 * GRN_WIDTH:base + 4 * GRN_WIDTH]
        attn = chunk_band_attention(q_a, k_a, v_a, rel_bias[l]).reshape(B, S, ATT_WIDTH)
        attn = rmsnorm(attn, attn_out_gain[l])
        rec = hgrn2_mixer(q_r, f_r, i_r, g_r, lb_all[l], grn_norm_gain[l])
        mixed = jnp.concatenate([attn, rec.astype(attn.dtype)], axis=-1)
        x = x + (mixed @ w_out[l]).astype(x.dtype)
        h2 = rmsnorm(x, norm2_gain[l])
        ff = jax.nn.silu(h2 @ w_gate[l]) * (h2 @ w_up[l])
        x = x + (ff @ w_down[l]).astype(x.dtype)
    return rmsnorm(x, final_gain)
```

```cpp
#include <hip/hip_runtime.h>
#include <cstdio>
#include <cstdint>

typedef unsigned short bf16_t;

constexpr int BATCH = 4, SEQ = 4096, DM = 2048, M = BATCH * SEQ;
constexpr int CHUNK = 64, NCH = SEQ / CHUNK, NLEFT = 8;
constexpr int AW = 1024, AH = 8, DH = 128, RELSZ = 257;
constexpr int GW = 1024, GH = 8, DK = 128, DV = 128;
constexpr int INC = 7168, DFF = 5632, NGU = 2 * DFF;
constexpr int QKVW = 3 * AW, RW = 4 * GW;
constexpr float EPS = 1e-6f;

constexpr size_t MiB = 1u << 20;
constexpr size_t WS_CTL = 0;
constexpr size_t WS_LB = 1 * MiB;
constexpr size_t WS_PART1 = 2 * MiB;
constexpr size_t WS_DEC = 4 * MiB;
constexpr size_t WS_SSQ = 5 * MiB;
constexpr size_t WS_QKV = 58 * MiB;
constexpr size_t WS_R = 154 * MiB;
constexpr size_t WS_FF = 58 * MiB;
constexpr size_t WS_MIX = 282 * MiB;
constexpr size_t WS_WDN = 346 * MiB;
constexpr size_t WS_WGU = 368 * MiB;
constexpr size_t WS_WOUT = 412 * MiB;
constexpr size_t WS_WIN = 420 * MiB;
constexpr size_t WS_H = 448 * MiB;
constexpr size_t WS_END = 512 * MiB;

__device__ __forceinline__ float bf2f(bf16_t v) { return __uint_as_float(((unsigned)v) << 16); }
__device__ __forceinline__ bf16_t f2bf(float f) { unsigned u = __float_as_uint(f); return (bf16_t)((u + 0x7fffu + ((u >> 16) & 1u)) >> 16); }

namespace pg8 {
#define PG8_LAS __attribute__((address_space(3)))
typedef short bf16x8 __attribute__((ext_vector_type(8)));
typedef float f32x4 __attribute__((ext_vector_type(4)));
typedef unsigned u32x4 __attribute__((ext_vector_type(4)));
typedef unsigned u32x2 __attribute__((ext_vector_type(2)));
constexpr int BM = 256, BK = 64, HALF = 128, HTB = HALF * BK * 2, STAGE_BYTES = 8 * HTB, NXCD = 8, WGM = 8;

__host__ __device__ __forceinline__ int lds_byte(int r, int c) { const int st = (r >> 4) * 2 + (c >> 5), rr = r & 15, cc = c & 31, ob = rr * 64 + cc * 2; return st * 1024 + (ob ^ (((ob >> 9) & 1) << 5)); }
__host__ __device__ __forceinline__ void stage_rc(int b, int& R, int& C) { const int st = b / 1024, sb = b % 1024, swz = sb ^ (((sb >> 9) & 1) << 5); R = (st >> 1) * 16 + swz / 64; C = (st & 1) * 32 + (swz % 64) / 2; }
__host__ __device__ __forceinline__ int perm32(int rho) { const int n = rho >> 4, i = rho & 15; return 8 * (i >> 2) + 4 * n + (i & 3); }

struct Unit { int pm, pn; };
struct Gemm { const bf16_t* A; const bf16_t* Bt; int M, N, K; };

struct StaticOrder {
    int nM, nN, nwg, G, c;
    __host__ __device__ void init(int M_, int N_, int G_, int c_) { nM = M_ / BM; nN = N_ / BM; nwg = nM * nN; G = G_; c = c_; }
    __host__ __device__ bool next(int i, Unit& u) const {
        const long L = (long)i * G + c; if (L >= nwg) return false;
        int wgid = (int)L; { const int q = nwg / NXCD, r = nwg % NXCD, xcd = wgid % NXCD, off = wgid / NXCD; wgid = (xcd < r ? xcd * (q + 1) : r * (q + 1) + (xcd - r) * q) + off; }
        const int nig = WGM * nN, gid = wgid / nig, fm = gid * WGM, gsz = (nM - fm) < WGM ? (nM - fm) : WGM;
        u.pm = fm + ((wgid % nig) % gsz); u.pn = (wgid % nig) / gsz; return true;
    }
};
typedef float f32x2_t __attribute__((ext_vector_type(2))); typedef __bf16 bf16x2_t __attribute__((ext_vector_type(2)));
__device__ __forceinline__ unsigned cvt_pk_bf16(float lo, float hi) { const f32x2_t v = {lo, hi}; const bf16x2_t b = __builtin_convertvector(v, bf16x2_t); return __builtin_bit_cast(unsigned, b); }

__device__ __forceinline__ void store16_wt(void* p, u32x4 v) { asm volatile("global_store_dwordx4 %0, %1, off sc1\n\ts_nop 1" :: "v"(p), "v"(v) : "memory"); }
struct EpiIn {
    static constexpr bool PERM = true;
    bf16_t* qkv; bf16_t* r;
    __device__ __forceinline__ void operator()(const f32x4 (&acc)[2][2][4][2], const Unit& u, int wr, int wc, int fr, int fq) const {
        const int row0 = u.pm * BM + wr * 64 + fr; int colt = u.pn * BM; bf16_t* base = qkv; int ldc = QKVW;
        const float sc = (colt < AW) ? 0.12751743104794074f : 1.0f;
        if (colt >= QKVW) { base = r; colt -= QKVW; ldc = RW; }
        const int col0 = colt + wc * 32 + 8 * fq;
#pragma unroll
        for (int ai = 0; ai < 2; ++ai)
#pragma unroll
            for (int m = 0; m < 4; ++m) { bf16_t* rowp = base + (size_t)(row0 + ai * HALF + m * 16) * ldc + col0;
#pragma unroll
                for (int bj = 0; bj < 2; ++bj) { const f32x4 v0 = acc[ai][bj][m][0] * sc, v1 = acc[ai][bj][m][1] * sc;
                    u32x4 w; w.x = cvt_pk_bf16(v0[0], v0[1]); w.y = cvt_pk_bf16(v0[2], v0[3]); w.z = cvt_pk_bf16(v1[0], v1[1]); w.w = cvt_pk_bf16(v1[2], v1[3]);
                    store16_wt(rowp + bj * HALF, w); } }
    }
};
struct EpiOut {
    static constexpr bool PERM = true;
    const float* x; bf16_t* x1b; float* part; const float* ssq; const PG8_LAS float* tab; int xp;
    __device__ __forceinline__ void operator()(const f32x4 (&acc)[2][2][4][2], const Unit& u, int wr, int wc, int fr, int fq) const {
        const int col0 = u.pn * BM + wc * 32 + 8 * fq;
        const bool intab = (u.pm >> 3) == xp;
#pragma unroll
        for (int ai = 0; ai < 2; ++ai) {
            f32x4 xv[4][2][2];
#pragma unroll
            for (int m = 0; m < 4; ++m) { const size_t off = (size_t)(u.pm * BM + ai * HALF + wr * 64 + m * 16 + fr) * DM + col0;
#pragma unroll
                for (int bj = 0; bj < 2; ++bj)
#pragma unroll
                    for (int n = 0; n < 2; ++n) xv[m][bj][n] = __builtin_nontemporal_load((const f32x4*)(x + off + bj * HALF + n * 4)); }
#pragma unroll
            for (int m = 0; m < 4; ++m) { const int rl = ai * HALF + wr * 64 + m * 16 + fr, r = u.pm * BM + rl; const size_t off = (size_t)r * DM + col0; float s = 0.f;
                float sa;
                if (intab) sa = tab[(u.pm & 7) * BM + rl];
                else { const f32x4 q0 = *(const f32x4*)(ssq + (size_t)r * AH), q1 = *(const f32x4*)(ssq + (size_t)r * AH + 4); sa = rsqrtf((((q0[0] + q0[1]) + (q0[2] + q0[3])) + ((q1[0] + q1[1]) + (q1[2] + q1[3]))) * (1.0f / AW) + EPS); }
#pragma unroll
                for (int bj = 0; bj < 2; ++bj) { const f32x4 y0 = xv[m][bj][0] + acc[ai][bj][m][0] * sa, y1 = xv[m][bj][1] + acc[ai][bj][m][1] * sa;
                    u32x4 w; w.x = cvt_pk_bf16(y0[0], y0[1]); w.y = cvt_pk_bf16(y0[2], y0[3]); w.z = cvt_pk_bf16(y1[0], y1[1]); w.w = cvt_pk_bf16(y1[2], y1[3]);
                    store16_wt(x1b + off + bj * HALF, w);
                    s += ((y0[0] * y0[0] + y0[1] * y0[1]) + (y0[2] * y0[2] + y0[3] * y0[3])) + ((y1[0] * y1[0] + y1[1] * y1[1]) + (y1[2] * y1[2] + y1[3] * y1[3])); }
                s += __shfl_xor(s, 16); s += __shfl_xor(s, 32);
                if (fq == 0) part[(size_t)r * 32 + u.pn * 4 + wc] = s; }
            asm volatile("" ::: "memory");
        }
    }
};
struct EpiGU {
    static constexpr bool PERM = true;
    const float* part; bf16_t* ff; const PG8_LAS float* tab; int xp;
    __device__ __forceinline__ void operator()(const f32x4 (&acc)[2][2][4][2], const Unit& u, int wr, int wc, int fr, int fq) const {
        const int col0 = u.pn * HALF + wc * 32 + 8 * fq;
        const bool intab = (u.pm >> 3) == xp;
#pragma unroll
        for (int ai = 0; ai < 2; ++ai)
#pragma unroll
            for (int m = 0; m < 4; ++m) { const int rl = ai * HALF + wr * 64 + m * 16 + fr, r = u.pm * BM + rl;
                float rs;
                if (intab) rs = tab[(u.pm & 7) * BM + rl];
                else { const f32x4* pp = (const f32x4*)(part + (size_t)r * 32); float sq = 0.f;
#pragma unroll
                    for (int i = 0; i < 8; ++i) { const f32x4 p = pp[i]; sq += (p[0] + p[1]) + (p[2] + p[3]); }
                    rs = rsqrtf(sq * (1.0f / DM) + EPS); }
                float o[8];
                const float c1 = -1.4426950408889634f * rs, c2 = rs * rs;
#pragma unroll
                for (int n = 0; n < 2; ++n)
#pragma unroll
                    for (int e = 0; e < 4; ++e) { const float g = acc[ai][0][m][n][e], up = acc[ai][1][m][n][e];
                        o[n * 4 + e] = (g * up) * (c2 * __builtin_amdgcn_rcpf(1.0f + __builtin_amdgcn_exp2f(c1 * g))); }
                u32x4 w; w.x = cvt_pk_bf16(o[0], o[1]); w.y = cvt_pk_bf16(o[2], o[3]); w.z = cvt_pk_bf16(o[4], o[5]); w.w = cvt_pk_bf16(o[6], o[7]);
                store16_wt(ff + (size_t)r * DFF + col0, w); }
    }
};
struct EpiDown {
    static constexpr bool PERM = true;
    const bf16_t* x1b; bf16_t* x2b;
    __device__ __forceinline__ void operator()(const f32x4 (&acc)[2][2][4][2], const Unit& u, int wr, int wc, int fr, int fq) const {
        const int col0 = u.pn * BM + wc * 32 + 8 * fq;
#pragma unroll
        for (int ai = 0; ai < 2; ++ai) {
            u32x4 xb[4][2];
#pragma unroll
            for (int m = 0; m < 4; ++m) { const size_t off = (size_t)(u.pm * BM + ai * HALF + wr * 64 + m * 16 + fr) * DM + col0;
#pragma unroll
                for (int bj = 0; bj < 2; ++bj) xb[m][bj] = __builtin_nontemporal_load((const u32x4*)(x1b + off + bj * HALF)); }
#pragma unroll
            for (int m = 0; m < 4; ++m) { const size_t off = (size_t)(u.pm * BM + ai * HALF + wr * 64 + m * 16 + fr) * DM + col0;
#pragma unroll
                for (int bj = 0; bj < 2; ++bj) { const u32x4 b = xb[m][bj]; const f32x4 a0 = acc[ai][bj][m][0], a1 = acc[ai][bj][m][1];
                    u32x4 w;
                    w.x = cvt_pk_bf16(__uint_as_float(b.x << 16) + a0[0], __uint_as_float(b.x & 0xffff0000u) + a0[1]);
                    w.y = cvt_pk_bf16(__uint_as_float(b.y << 16) + a0[2], __uint_as_float(b.y & 0xffff0000u) + a0[3]);
                    w.z = cvt_pk_bf16(__uint_as_float(b.z << 16) + a1[0], __uint_as_float(b.z & 0xffff0000u) + a1[1]);
                    w.w = cvt_pk_bf16(__uint_as_float(b.w << 16) + a1[2], __uint_as_float(b.w & 0xffff0000u) + a1[3]);
                    store16_wt(x2b + off + bj * HALF, w); } }
            asm volatile("" ::: "memory");
        }
    }
};

template <class Epi, class Sched, bool ALIGN_EPI = false, bool SP2 = false>
__device__ __forceinline__ void gemm_phase(PG8_LAS unsigned char* lds, const Gemm g, const Sched& S, const Epi& E) {
    const int tid = threadIdx.x, wid = __builtin_amdgcn_readfirstlane(tid >> 6), lane = tid & 63, wr = wid >> 2, wc = wid & 3, fr = lane & 15, fq = lane >> 4;
    const int K = g.K, nt = K / BK;
    unsigned voffA[2], voffB[2];
#pragma unroll
    for (int i = 0; i < 2; ++i) { int R, C; stage_rc(tid * 16 + i * 8192, R, C); const int Rb = Epi::PERM ? ((R & ~31) + perm32(R & 31)) : R;
        voffA[i] = (unsigned)(R * K + C) * 2u; voffB[i] = (unsigned)(Rb * K + C) * 2u; }
    const size_t kstep = (size_t)(BK * 2);
    const size_t hstep = (size_t)HALF * K * 2;
    const size_t tstep = 2 * hstep;
    const unsigned ldsw = (unsigned)wid * 1024u;
    const int aoff = lds_byte(wr * 64 + fr, fq * 8), boff = lds_byte(wc * 32 + fr, fq * 8);
#define PG8_SA(b, h) (((b) * 2 + (h)) * HTB)
#define PG8_SB(b, h) ((4 + (b) * 2 + (h)) * HTB)
#define PG8_STAGE(bufoff, gbase, voff) do { _Pragma("unroll") for (int _i = 0; _i < 2; ++_i) \
        __builtin_amdgcn_global_load_lds((const unsigned*)((const char*)(gbase) + (voff)[_i]), (PG8_LAS unsigned*)(lds + (bufoff) + ldsw + _i * 8192), 16, 0, 0); } while (0)
#define PG8_LDA(dst, b, h) do { _Pragma("unroll") for (int m = 0; m < 4; ++m) _Pragma("unroll") for (int k = 0; k < 2; ++k) dst[m][k] = *(const PG8_LAS bf16x8*)(lds + PG8_SA(b, h) + aoff + m * 2048 + k * 1024); } while (0)
#define PG8_LDB(dst, b, h) do { _Pragma("unroll") for (int n = 0; n < 2; ++n) _Pragma("unroll") for (int k = 0; k < 2; ++k) dst[n][k] = *(const PG8_LAS bf16x8*)(lds + PG8_SB(b, h) + boff + n * 2048 + k * 1024); } while (0)
#define PG8_MMA(ai, bj, At, Bt) do { __builtin_amdgcn_s_setprio(1); _Pragma("unroll") for (int m = 0; m < 4; ++m) _Pragma("unroll") for (int n = 0; n < 2; ++n) _Pragma("unroll") for (int k = 0; k < 2; ++k) \
        acc[ai][bj][m][n] = __builtin_amdgcn_mfma_f32_16x16x32_bf16(Bt[n][k], At[m][k], acc[ai][bj][m][n], 0, 0, 0); __builtin_amdgcn_s_setprio(0); } while (0)
#define PG8_WAIT_V(n) asm volatile("s_waitcnt vmcnt(" #n ")" ::: "memory")
#define PG8_WAIT_L(n) asm volatile("s_waitcnt lgkmcnt(" #n ")" ::: "memory")
#define PG8_BAR __builtin_amdgcn_s_barrier()
#define PG8_SCHED __builtin_amdgcn_sched_barrier(0)
    Unit cur, nxt; int ui = 0;
    if (!S.next(0, cur)) return;
    f32x4 acc[2][2][4][2];
#pragma unroll
    for (int a = 0; a < 2; ++a)
#pragma unroll
        for (int b = 0; b < 2; ++b)
#pragma unroll
            for (int m = 0; m < 4; ++m)
#pragma unroll
                for (int n = 0; n < 2; ++n) acc[a][b][m][n] = (f32x4){0.f, 0.f, 0.f, 0.f};
    bf16x8 At[4][2], B0[2][2], B1[2][2];
    const char* cA = (const char*)g.A + (size_t)cur.pm * tstep; const char* cB = (const char*)g.Bt + (size_t)cur.pn * tstep;
    if constexpr (SP2) {
        PG8_STAGE(PG8_SB(0, 0), cB, voffB); PG8_STAGE(PG8_SB(0, 1), cB + hstep, voffB); PG8_STAGE(PG8_SA(0, 0), cA, voffA); PG8_STAGE(PG8_SA(0, 1), cA + hstep, voffA);
        if (wr == 1) PG8_BAR;
        PG8_WAIT_V(2); PG8_BAR;
        PG8_STAGE(PG8_SB(1, 0), cB + kstep, voffB); PG8_STAGE(PG8_SA(1, 0), cA + kstep, voffA); PG8_STAGE(PG8_SB(1, 1), cB + hstep + kstep, voffB);
        PG8_WAIT_V(6); PG8_BAR;
    } else {
        PG8_STAGE(PG8_SB(0, 0), cB, voffB); PG8_STAGE(PG8_SA(0, 0), cA, voffA); PG8_STAGE(PG8_SB(0, 1), cB + hstep, voffB); PG8_STAGE(PG8_SA(0, 1), cA + hstep, voffA);
        if (wr == 1) PG8_BAR;
        PG8_WAIT_V(4); PG8_BAR;
        PG8_STAGE(PG8_SB(1, 0), cB + kstep, voffB); PG8_STAGE(PG8_SA(1, 0), cA + kstep, voffA); PG8_STAGE(PG8_SB(1, 1), cB + hstep + kstep, voffB);
        PG8_WAIT_V(6); PG8_BAR;
    }
    for (;;) {
        const bool has_next = S.next(ui + 1, nxt);
        const char* nA = has_next ? (const char*)g.A + (size_t)nxt.pm * tstep : cA; const char* nB = has_next ? (const char*)g.Bt + (size_t)nxt.pn * tstep : cB;
        for (int t = 0; t < nt; t += 2) {
            const bool last = (t == nt - 2);
            const char* a1 = cA + (size_t)(t + 1) * kstep;
            const char* a2 = last ? nA : cA + (size_t)(t + 2) * kstep; const char* b2 = last ? nB : cB + (size_t)(t + 2) * kstep;
            const char* a3 = a2 + kstep; const char* b3 = b2 + kstep;
            if constexpr (SP2) {
            PG8_LDB(B0, 0, 0); PG8_LDB(B1, 0, 1); PG8_SCHED; PG8_LDA(At, 0, 0); PG8_STAGE(PG8_SA(1, 1), a1 + hstep, voffA);
            PG8_WAIT_V(8); PG8_WAIT_L(0); PG8_BAR; PG8_MMA(0, 0, At, B0); PG8_MMA(0, 1, At, B1); PG8_BAR; PG8_SCHED;
            PG8_LDA(At, 0, 1); PG8_STAGE(PG8_SB(0, 0), b2, voffB); PG8_STAGE(PG8_SB(0, 1), b2 + hstep, voffB); PG8_STAGE(PG8_SA(0, 0), a2, voffA);
            PG8_WAIT_V(8); PG8_WAIT_L(0); PG8_BAR; PG8_MMA(1, 0, At, B0); PG8_MMA(1, 1, At, B1); PG8_BAR; PG8_SCHED;
            PG8_LDB(B0, 1, 0); PG8_LDB(B1, 1, 1); PG8_SCHED; PG8_LDA(At, 1, 0); PG8_STAGE(PG8_SA(0, 1), a2 + hstep, voffA);
            PG8_WAIT_V(8); PG8_WAIT_L(0); PG8_BAR; PG8_MMA(0, 0, At, B0); PG8_MMA(0, 1, At, B1); PG8_BAR; PG8_SCHED;
            PG8_LDA(At, 1, 1); PG8_STAGE(PG8_SB(1, 0), b3, voffB); PG8_STAGE(PG8_SB(1, 1), b3 + hstep, voffB); PG8_STAGE(PG8_SA(1, 0), a3, voffA);
            PG8_WAIT_V(8); PG8_WAIT_L(0); PG8_BAR; PG8_MMA(1, 0, At, B0); PG8_MMA(1, 1, At, B1); PG8_BAR; PG8_SCHED;
            } else {
            PG8_LDB(B0, 0, 0); PG8_SCHED; PG8_LDA(At, 0, 0); PG8_STAGE(PG8_SA(1, 1), a1 + hstep, voffA);
            PG8_WAIT_L(8); PG8_BAR; PG8_WAIT_L(0); PG8_MMA(0, 0, At, B0); PG8_BAR; PG8_SCHED;
            PG8_LDB(B1, 0, 1); PG8_STAGE(PG8_SB(0, 0), b2, voffB);
            PG8_BAR; PG8_WAIT_L(0); PG8_MMA(0, 1, At, B1); PG8_BAR;
            PG8_LDA(At, 0, 1); PG8_STAGE(PG8_SA(0, 0), a2, voffA);
            PG8_BAR; PG8_WAIT_L(0); PG8_MMA(1, 0, At, B0); PG8_BAR; PG8_SCHED;
            PG8_STAGE(PG8_SB(0, 1), b2 + hstep, voffB);
            PG8_WAIT_V(6); PG8_BAR; PG8_MMA(1, 1, At, B1); PG8_BAR;
            PG8_LDB(B0, 1, 0); PG8_SCHED; PG8_LDA(At, 1, 0); PG8_STAGE(PG8_SA(0, 1), a2 + hstep, voffA);
            PG8_WAIT_L(8); PG8_BAR; PG8_WAIT_L(0); PG8_MMA(0, 0, At, B0); PG8_BAR; PG8_SCHED;
            PG8_LDB(B1, 1, 1); PG8_STAGE(PG8_SB(1, 0), b3, voffB);
            PG8_BAR; PG8_WAIT_L(0); PG8_MMA(0, 1, At, B1); PG8_BAR;
            PG8_LDA(At, 1, 1); PG8_STAGE(PG8_SA(1, 0), a3, voffA);
            PG8_BAR; PG8_WAIT_L(0); PG8_MMA(1, 0, At, B0); PG8_BAR; PG8_SCHED;
            PG8_STAGE(PG8_SB(1, 1), b3 + hstep, voffB);
            PG8_WAIT_V(6); PG8_BAR; PG8_MMA(1, 1, At, B1); PG8_BAR;
            }
        }
        if constexpr (ALIGN_EPI) { if (wr == 0) PG8_BAR; }
        E(acc, cur, wr, wc, fr, fq);
        if (!has_next) break;
#pragma unroll
        for (int a = 0; a < 2; ++a)
#pragma unroll
            for (int b = 0; b < 2; ++b)
#pragma unroll
                for (int m = 0; m < 4; ++m)
#pragma unroll
                    for (int n = 0; n < 2; ++n) acc[a][b][m][n] = (f32x4){0.f, 0.f, 0.f, 0.f};
        cur = nxt; cA = nA; cB = nB; ++ui;
        if constexpr (ALIGN_EPI) { if (wr == 1) PG8_BAR; }
    }
    PG8_WAIT_V(0);
    if constexpr (!ALIGN_EPI) { if (wr == 0) PG8_BAR; }
    PG8_BAR;
#undef PG8_SA
#undef PG8_SB
#undef PG8_STAGE
#undef PG8_LDA
#undef PG8_LDB
#undef PG8_MMA
#undef PG8_WAIT_V
#undef PG8_WAIT_L
#undef PG8_BAR
#undef PG8_SCHED
}
}

#define GAS __attribute__((address_space(1)))
#define LAS __attribute__((address_space(3)))
typedef unsigned v4u __attribute__((ext_vector_type(4)));
typedef unsigned v2u __attribute__((ext_vector_type(2)));
typedef float f32x4 __attribute__((ext_vector_type(4)));
typedef float f32x16 __attribute__((ext_vector_type(16)));
typedef short bf16x8 __attribute__((ext_vector_type(8)));
typedef short s16x4 __attribute__((ext_vector_type(4)));
typedef GAS unsigned gu32;
#define RLX_AGENT __ATOMIC_RELAXED, __HIP_MEMORY_SCOPE_AGENT
#define LDS_WAIT() asm volatile("s_waitcnt lgkmcnt(0)" ::: "memory")

constexpr int NWAVES = 8, NTHR = 512;
constexpr int RING_BYTES = 131072, MISC_OFF = RING_BYTES + 320, LDS_BYTES = 147456;
constexpr int CW_BAR = 4096;
constexpr int TAB_OFF = RING_BYTES + 1024;
constexpr size_t CTL_ZERO_BYTES = 64 * 1024;

#define XB_TMO      128
#define XB_XCNT(j)  (256  + 64 * (j))
#define XB_XSUB(j)  (1280 + 64 * (j))
#define XB_XGEN(j)  (2304 + 64 * (j))
#define XB_TOP      3328
#define XB_TOPGEN   3392
#define XCD_BAR_WORDS 3456
#define XB_SPIN_CAP (1u << 22)
__device__ __forceinline__ unsigned xb_ld(unsigned* p)              { return __hip_atomic_load(p, __ATOMIC_RELAXED, __HIP_MEMORY_SCOPE_AGENT); }
__device__ __forceinline__ unsigned xb_add(unsigned* p, unsigned v) { return __hip_atomic_fetch_add(p, v, __ATOMIC_RELAXED, __HIP_MEMORY_SCOPE_AGENT); }
__device__ __forceinline__ unsigned xb_xcc_id() { return (unsigned)__builtin_amdgcn_s_getreg((3 << 11) | 20) & 0xFu; }
#define XB_SPIN(cond, bar) do { unsigned _sp = 0; while (cond) { __builtin_amdgcn_s_sleep(1); \
    if ((++_sp & 255u) == 0u) { if (xb_ld(&(bar)[XB_TMO])) break; if (_sp > XB_SPIN_CAP) { atomicAdd(&(bar)[XB_TMO], 1u); break; } } } } while (0)
struct XcdBarrier { unsigned* bar; unsigned x; volatile LAS unsigned* st; };
__device__ __forceinline__ XcdBarrier xcd_barrier_post(unsigned* bar, volatile LAS unsigned* st) {
    XcdBarrier b; b.bar = bar; b.x = xb_xcc_id(); b.st = st;
    if (threadIdx.x == 0) (void)xb_add(&bar[XB_XCNT(b.x)], 1u);
    return b;
}
__device__ __forceinline__ void xcd_barrier_complete(unsigned* bar, unsigned x, unsigned& nloc, unsigned& nx) {
    const unsigned G = gridDim.x * gridDim.y * gridDim.z;
    unsigned sum, cnt, mine, sp = 0u;
    for (;;) {
        sum = 0u; cnt = 0u; mine = 0u;
#pragma unroll
        for (unsigned j = 0; j < 16; ++j) { const unsigned c = xb_ld(&bar[XB_XCNT(j)]); sum += c; cnt += (c > 0u) ? 1u : 0u; mine = (j == x) ? c : mine; }
        if (sum == G) break;
        __builtin_amdgcn_s_sleep(1);
        if ((++sp & 255u) == 0u) { if (xb_ld(&bar[XB_TMO])) break; if (sp > XB_SPIN_CAP) { atomicAdd(&bar[XB_TMO], 1u); break; } }
    }
    nloc = mine > 0u ? mine : 1u; nx = cnt > 0u ? cnt : 1u;
}
__device__ __forceinline__ void xcd_barrier(const XcdBarrier& b) {
    asm volatile("s_waitcnt vmcnt(0)" ::: "memory");
    __syncthreads();
    if (threadIdx.x == 0) {
        unsigned* bar = b.bar;
        __builtin_amdgcn_s_waitcnt(0);
        unsigned nloc = b.st[0], nx = b.st[1];
        if (nloc == 0u) { xcd_barrier_complete(bar, b.x, nloc, nx); b.st[0] = nloc; b.st[1] = nx; }
        const unsigned old = xb_add(&bar[XB_XSUB(b.x)], 1u);
        const unsigned gen = old / nloc;
        if (old + 1u == (gen + 1u) * nloc) {
            __builtin_amdgcn_fence(__ATOMIC_RELEASE, "agent");
            asm volatile("s_waitcnt vmcnt(0)" ::: "memory");
            const unsigned og = xb_add(&bar[XB_TOP], 1u);
            const unsigned tg = og / nx;
            if (og + 1u == (tg + 1u) * nx) xb_add(&bar[XB_TOPGEN], 1u);
            else XB_SPIN(xb_ld(&bar[XB_TOPGEN]) == tg, bar);
            __builtin_amdgcn_fence(__ATOMIC_ACQUIRE, "agent");
            xb_add(&bar[XB_XGEN(b.x)], 1u);
            asm volatile("s_waitcnt vmcnt(0)" ::: "memory");
        } else {
            XB_SPIN(xb_ld(&bar[XB_XGEN(b.x)]) == gen, bar);
            __builtin_amdgcn_fence(__ATOMIC_ACQUIRE, "agent");
            asm volatile("s_waitcnt vmcnt(0)" ::: "memory");
        }
    }
    __syncthreads();
}

struct Args { const float* in[13]; float* out; unsigned char* ws; int ph_lo, ph_hi, flags, pad; };

struct Frame {
    LAS unsigned char* lds; int tid, lane, wave, vcu, G;
    const float *x, *g1, *w_in, *relb, *lower, *gng, *aog, *w_out, *g2, *w_gate, *w_up, *w_down, *gf;
    float* out; float *LB, *PART1, *DEC, *SSQ;
    bf16_t *WIN, *WOUT, *WGU, *WDN, *H, *QKV, *R, *FF, *MIX;
};

__device__ __forceinline__ float wave_sum(float v) {
#pragma unroll
    for (int o = 1; o < 64; o <<= 1) v += __shfl_xor(v, o);
    return v;
}
__device__ __forceinline__ unsigned pk2(float lo, float hi) { return pg8::cvt_pk_bf16(lo, hi); }
__device__ __forceinline__ int crow(int r, int hi) { return (r & 3) + 8 * (r >> 2) + 4 * hi; }
__device__ __forceinline__ void store_pair16(bf16_t* base16, v2u a, v2u b, int hi) {
    const auto rx = __builtin_amdgcn_permlane32_swap(a.x, b.x, false, false); const auto ry = __builtin_amdgcn_permlane32_swap(a.y, b.y, false, false);
    pg8::u32x4 w; w.x = rx[0]; w.y = ry[0]; w.z = rx[1]; w.w = ry[1];
    pg8::store16_wt(base16 + (hi ? 8 : 0), w);
}

template <int MODE>
__device__ __forceinline__ void p0_transpose_item(const float* W, int K, int N, bf16_t* WT, int which, const float* ks, LAS float* scr, int item, int lane) {
    const int nblk = N / 32, kb = item / nblk, nb = item % nblk, k0 = 64 * kb, n0 = 32 * nb;
    f32x4 v[8];
    const float* wp = W + (size_t)(k0 + (lane >> 3)) * N + n0 + 4 * (lane & 7);
#pragma unroll
    for (int i = 0; i < 8; ++i) v[i] = __builtin_nontemporal_load((const GAS f32x4*)(wp + (size_t)(8 * i) * N));
#pragma unroll
    for (int i = 0; i < 8; ++i) { const int kk = 8 * i + (lane >> 3); f32x4 x = v[i]; if (MODE == 1) x = x * ks[k0 + kk];
        LAS float* d = scr + kk * 33 + 4 * (lane & 7); d[0] = x.x; d[1] = x.y; d[2] = x.z; d[3] = x.w; }
    LDS_WAIT(); asm volatile("" ::: "memory");
    const int c = lane & 7;
#pragma unroll
    for (int j = 0; j < 4; ++j) { const int nl = (lane >> 3) + 8 * j; const LAS float* s = scr + (8 * c) * 33 + nl; const int n = n0 + nl;
        const int row = (MODE == 0) ? n : (256 * (n >> 7) + 128 * which + (n & 127));
        v4u o; o.x = pk2(s[0 * 33], s[1 * 33]); o.y = pk2(s[2 * 33], s[3 * 33]); o.z = pk2(s[4 * 33], s[5 * 33]); o.w = pk2(s[6 * 33], s[7 * 33]);
        *(GAS v4u*)(WT + (size_t)row * K + k0 + 8 * c) = o; }
    LDS_WAIT(); asm volatile("" ::: "memory");
}
__device__ __forceinline__ void rms_row_to_bf16(const float* xrow, const float* gain, bf16_t* orow, int lane) {
    const GAS f32x4* xr = (const GAS f32x4*)xrow + lane; const GAS f32x4* gr = (const GAS f32x4*)gain + lane;
    f32x4 v[8]; float s = 0.f;
#pragma unroll
    for (int j = 0; j < 8; ++j) { v[j] = __builtin_nontemporal_load(xr + 64 * j); s += (v[j].x * v[j].x + v[j].y * v[j].y) + (v[j].z * v[j].z + v[j].w * v[j].w); }
    const float r = rsqrtf(wave_sum(s) * (1.f / DM) + EPS);
    GAS v2u* o8 = (GAS v2u*)orow + lane;
#pragma unroll
    for (int j = 0; j < 8; ++j) { const f32x4 g = gr[64 * j]; v2u w; w.x = pk2(v[j].x * r * g.x, v[j].y * r * g.y); w.y = pk2(v[j].z * r * g.z, v[j].w * r * g.w); o8[64 * j] = w; }
}
__device__ __forceinline__ void p0_prologue(Frame& F) {
    LAS float* scr = (LAS float*)(F.lds + F.wave * 16384);
    const int gw = F.vcu * NWAVES + F.wave, NGW = F.G * NWAVES;
    constexpr int I_IN = (DM / 64) * (INC / 32), I_OUT = (DM / 64) * (DM / 32), I_G = (DM / 64) * (DFF / 32), I_DN = (DFF / 64) * (DM / 32);
    constexpr int NITEMS = I_IN + I_OUT + 2 * I_G + I_DN;
    for (int it = gw; it < NITEMS; it += NGW) {
        int r = it;
        if (r < I_IN) { p0_transpose_item<0>(F.w_in, DM, INC, F.WIN, 0, nullptr, scr, r, F.lane); continue; } r -= I_IN;
        if (r < I_OUT) { p0_transpose_item<0>(F.w_out, DM, DM, F.WOUT, 0, nullptr, scr, r, F.lane); continue; } r -= I_OUT;
        if (r < I_G) { p0_transpose_item<1>(F.w_gate, DM, DFF, F.WGU, 0, F.g2, scr, r, F.lane); continue; } r -= I_G;
        if (r < I_G) { p0_transpose_item<1>(F.w_up, DM, DFF, F.WGU, 1, F.g2, scr, r, F.lane); continue; } r -= I_G;
        p0_transpose_item<0>(F.w_down, DFF, DM, F.WDN, 0, nullptr, scr, r, F.lane);
    }
    for (int m = gw; m < M; m += NGW) rms_row_to_bf16(F.x + (size_t)m * DM, F.g1, F.H + (size_t)m * DM, F.lane);
    const int gt = F.vcu * NTHR + F.tid;
    if (gt < GW) { const float a = F.lower[gt], b = F.lower[GW + gt], mx = fmaxf(a, b); const float ea = __expf(a - mx), eb = __expf(b - mx); F.LB[gt] = ea / (ea + eb); }
}
__device__ __forceinline__ void p8_final(Frame& F) {
    const int gw = F.vcu * NWAVES + F.wave, NGW = F.G * NWAVES;
    const GAS f32x4* gr = (const GAS f32x4*)F.gf + 2 * F.lane;
    for (int m = gw; m < M; m += 2 * NGW) {
        const int m1 = m + NGW; const bool two = m1 < M;
        const GAS v4u* xr0 = (const GAS v4u*)(F.MIX + (size_t)m * DM) + F.lane; const GAS v4u* xr1 = (const GAS v4u*)(F.MIX + (size_t)(two ? m1 : m) * DM) + F.lane;
        v4u b0[4], b1[4];
#pragma unroll
        for (int j = 0; j < 4; ++j) { b0[j] = __builtin_nontemporal_load(xr0 + 64 * j); b1[j] = __builtin_nontemporal_load(xr1 + 64 * j); }
#pragma unroll
        for (int rr = 0; rr < 2; ++rr) {
            if (rr == 1 && !two) break;
            float v[4][8]; float s = 0.f;
#pragma unroll
            for (int j = 0; j < 4; ++j) { const v4u bb = rr ? b1[j] : b0[j]; const unsigned w[4] = {bb.x, bb.y, bb.z, bb.w};
#pragma unroll
                for (int e = 0; e < 4; ++e) { v[j][2 * e] = __uint_as_float(w[e] << 16); v[j][2 * e + 1] = __uint_as_float(w[e] & 0xffff0000u); s += v[j][2 * e] * v[j][2 * e] + v[j][2 * e + 1] * v[j][2 * e + 1]; } }
            const float r = rsqrtf(wave_sum(s) * (1.f / DM) + EPS);
            GAS f32x4* orow = (GAS f32x4*)(F.out + (size_t)(rr ? m1 : m) * DM) + 2 * F.lane;
#pragma unroll
            for (int j = 0; j < 4; ++j) { const f32x4 g0 = gr[128 * j], g1 = gr[128 * j + 1];
                __builtin_nontemporal_store((f32x4){v[j][0] * r * g0.x, v[j][1] * r * g0.y, v[j][2] * r * g0.z, v[j][3] * r * g0.w}, orow + 128 * j);
                __builtin_nontemporal_store((f32x4){v[j][4] * r * g1.x, v[j][5] * r * g1.y, v[j][6] * r * g1.z, v[j][7] * r * g1.w}, orow + 128 * j + 1); }
        }
    }
}

typedef short v4i16_t __attribute__((ext_vector_type(4)));
__device__ __forceinline__ s16x4 vtr(LAS unsigned char* p) { return __builtin_bit_cast(s16x4, __builtin_amdgcn_ds_read_tr16_b64_v4i16((LAS v4i16_t*)p)); }
__device__ __forceinline__ bf16x8 tr2(LAS unsigned char* p, int second_off) { const s16x4 a = vtr(p), b = vtr(p + second_off); return (bf16x8){a[0], a[1], a[2], a[3], b[0], b[1], b[2], b[3]}; }
#define MFMA32(a, b, c) __builtin_amdgcn_mfma_f32_32x32x16_bf16((a), (b), (c), 0, 0, 0)
__device__ __forceinline__ bf16x8 pack8(const f32x16& p, int s2) {
    v4u w; w.x = pk2(p[8 * s2 + 0], p[8 * s2 + 1]); w.y = pk2(p[8 * s2 + 2], p[8 * s2 + 3]); w.z = pk2(p[8 * s2 + 4], p[8 * s2 + 5]); w.w = pk2(p[8 * s2 + 6], p[8 * s2 + 7]);
    return __builtin_bit_cast(bf16x8, w);
}
__device__ __forceinline__ float xmax32(float v) { const auto rr = __builtin_amdgcn_permlane32_swap(__float_as_uint(v), __float_as_uint(v), false, false); return fmaxf(__uint_as_float(rr[0]), __uint_as_float(rr[1])); }
__device__ __forceinline__ float xsum32(float v) { const auto rr = __builtin_amdgcn_permlane32_swap(__float_as_uint(v), __float_as_uint(v), false, false); return __uint_as_float(rr[0]) + __uint_as_float(rr[1]); }
#define WG_BAR() do { asm volatile("s_waitcnt lgkmcnt(0)" ::: "memory"); __builtin_amdgcn_s_barrier(); asm volatile("" ::: "memory"); } while (0)
constexpr int AT_KP = 272, AT_VP = 320, AT_KT = 64 * AT_KP, AT_VT = 64 * AT_VP, AT_BUF = AT_KT + AT_VT, AT_BIAS = 2 * AT_BUF, AT_NT = 12;
__device__ __forceinline__ void attn_phase(Frame& F) {
    const int lane = F.lane, w = F.wave, r32 = lane & 31, hi = lane >> 5, cwl = w >> 1, qb = w & 1;
    LAS float* bw = (LAS float*)(F.lds + AT_BIAS);
    constexpr float LOG2E = 1.4426950408889634f;
    const int trq = (lane & 15) >> 2, trc = 16 * ((lane >> 4) & 1) + 4 * (lane & 3);
    const int srow = F.tid >> 4, sch = F.tid & 15;
    const int iq = 32 * qb + r32;
    const int bg = F.vcu * NTHR + F.tid; const bool bhas = bg < BATCH * GH * DK * (DV / 4);
    bf16_t* bU = ((bf16_t*)F.out + (size_t)32 * 1024 * 1024); const float* bD = F.DEC; int bc = bhas ? 0 : NCH; f32x4 bs = (f32x4){0.f, 0.f, 0.f, 0.f};
    if (bhas) { const int bh = bg >> 12, k = (bg >> 5) & 127, v4 = bg & 31, b_ = bh >> 3, h_ = bh & 7; bU += ((size_t)(b_ * NCH) * 8 + h_) * (DK * DV) + k * DV + v4 * 4; bD += ((size_t)(b_ * NCH) * 8 + h_) * DK + k; }
    constexpr size_t BUS = (size_t)8 * DK * DV; constexpr int BDS = 8 * DK;
    for (int item = F.vcu; item < BATCH * AH * (NCH / 4); item += F.G) {
        const int cg = item & 15, h = (item >> 4) & 7, b = item >> 7;
        { const float bfar_ = F.relb[h * RELSZ + 256];
          for (int t = F.tid; t < 640; t += NTHR) { int d = NLEFT * CHUNK + 63 - t; d = d > 128 ? 128 : d; bw[t] = (F.relb[h * RELSZ + d + 128] - bfar_) * LOG2E; } }
        const size_t tokq = (size_t)b * SEQ + (size_t)(4 * cg + cwl) * CHUNK + iq;
        bf16x8 qf[8];
        { const bf16_t* qp = F.QKV + tokq * QKVW + h * DH + 8 * hi;
#pragma unroll
          for (int ks = 0; ks < 8; ++ks) qf[ks] = *(const bf16x8*)(qp + 16 * ks); }
        const int T0 = (cg >= 2) ? 0 : (NLEFT - 4 * cg);
        const bf16_t* sbase = F.QKV + ((long)b * SEQ + (long)(4 * cg - NLEFT) * CHUNK + srow) * QKVW + AW + h * DH + 8 * sch;
        LAS unsigned char* kdst = F.lds + srow * AT_KP + sch * 16; LAS unsigned char* vdst = F.lds + AT_KT + srow * AT_VP + sch * 16;
        v4u kr0, kr1, vr0, vr1;
#define AT_LOAD(T_) do { const bf16_t* sp_ = sbase + (size_t)(64 * (T_)) * QKVW; kr0 = *(const v4u*)sp_; kr1 = *(const v4u*)(sp_ + (size_t)32 * QKVW); vr0 = *(const v4u*)(sp_ + AW); vr1 = *(const v4u*)(sp_ + (size_t)32 * QKVW + AW); } while (0)
#define AT_STORE(bufoff) do { *(LAS v4u*)(kdst + (bufoff)) = kr0; *(LAS v4u*)(kdst + (bufoff) + 32 * AT_KP) = kr1; *(LAS v4u*)(vdst + (bufoff)) = vr0; *(LAS v4u*)(vdst + (bufoff) + 32 * AT_VP) = vr1; } while (0)
        AT_LOAD(T0); AT_STORE(0); AT_LOAD(T0 + 1);
        f32x16 o[4];
#pragma unroll
        for (int db = 0; db < 4; ++db)
#pragma unroll
            for (int r = 0; r < 16; ++r) o[db][r] = 0.f;
        float mrun = 0.f, lrun = 0.f; bool first = true;
        f32x16 negm;
#pragma unroll
        for (int r = 0; r < 16; ++r) negm[r] = 0.f;
        WG_BAR();
        for (int T = T0; T < AT_NT; ++T) {
            const int cur = (T - T0) & 1;
            if (T + 1 < AT_NT) AT_STORE((cur ^ 1) * AT_BUF);
            if (T + 2 < AT_NT) AT_LOAD(T + 2);
            v2u bu[4]; float bd[4]; const bool bact = bc < NCH;
            if (bact) {
#pragma unroll
                for (int j = 0; j < 4; ++j) { bu[j] = *(const v2u*)(bU + (size_t)(bc + j) * BUS); bd[j] = bD[(bc + j) * BDS]; }
            }
            const int kc = T - cwl;
            if (kc >= 0 && kc <= NLEFT) {
                LAS unsigned char* kb = F.lds + cur * AT_BUF + r32 * AT_KP + 16 * hi;
                LAS unsigned char* vtr0 = F.lds + cur * AT_BUF + AT_KT + (4 * hi + trq) * AT_VP + trc * 2;
                f32x16 s0 = negm, s1 = negm;
                __builtin_amdgcn_s_setprio(1);
#pragma unroll
                for (int ks = 0; ks < 8; ++ks) { s0 = MFMA32(*(LAS bf16x8*)(kb + 32 * ks), qf[ks], s0); s1 = MFMA32(*(LAS bf16x8*)(kb + 32 * AT_KP + 32 * ks), qf[ks], s1); }
                __builtin_amdgcn_s_setprio(0);
                if (kc >= 6) {
                    const LAS float* bp = bw + (64 * kc + 63 - iq + 4 * hi);
#pragma unroll
                    for (int r = 0; r < 16; ++r) { s0[r] += bp[(r & 3) + 8 * (r >> 2)]; s1[r] += bp[32 + (r & 3) + 8 * (r >> 2)]; }
                }
                float mx = fmaxf(s0[0], s1[0]);
#pragma unroll
                for (int r = 1; r < 16; ++r) mx = fmaxf(mx, fmaxf(s0[r], s1[r]));
                mx = xmax32(mx);
                if (first || __builtin_amdgcn_ballot_w64(mx > 0.f) != 0ull) {
                    const float dl = first ? mx : fmaxf(mx, 0.f);
                    mrun += dl;
#pragma unroll
                    for (int r = 0; r < 16; ++r) { s0[r] -= dl; s1[r] -= dl; negm[r] = -mrun; }
                    if (!first) { const float al = __builtin_amdgcn_exp2f(-dl); lrun *= al;
#pragma unroll
                        for (int db = 0; db < 4; ++db)
#pragma unroll
                            for (int r = 0; r < 16; ++r) o[db][r] *= al; }
                    first = false;
                }
                float rs0 = 0.f, rs1 = 0.f;
#pragma unroll
                for (int r = 0; r < 16; ++r) { s0[r] = __builtin_amdgcn_exp2f(s0[r]); s1[r] = __builtin_amdgcn_exp2f(s1[r]); rs0 += s0[r]; rs1 += s1[r]; }
                lrun += xsum32(rs0 + rs1);
                const bf16x8 pb0 = pack8(s0, 0), pb1 = pack8(s0, 1), pb2 = pack8(s1, 0), pb3 = pack8(s1, 1);
#pragma unroll
                for (int db = 0; db < 4; ++db) {
                    const bf16x8 a0 = tr2(vtr0 + db * 64, 8 * AT_VP), a1 = tr2(vtr0 + 16 * AT_VP + db * 64, 8 * AT_VP);
                    const bf16x8 a2 = tr2(vtr0 + 32 * AT_VP + db * 64, 8 * AT_VP), a3 = tr2(vtr0 + 48 * AT_VP + db * 64, 8 * AT_VP);
                    __builtin_amdgcn_s_setprio(1);
                    o[db] = MFMA32(a0, pb0, o[db]); o[db] = MFMA32(a1, pb1, o[db]); o[db] = MFMA32(a2, pb2, o[db]); o[db] = MFMA32(a3, pb3, o[db]);
                    __builtin_amdgcn_s_setprio(0);
                }
            }
            if (bact) {
#pragma unroll
                for (int j = 0; j < 4; ++j) { v2u wv; wv.x = pk2(bs.x, bs.y); wv.y = pk2(bs.z, bs.w); *(v2u*)(bU + (size_t)(bc + j) * BUS) = wv;
                    const f32x4 uf = (f32x4){__uint_as_float(bu[j].x << 16), __uint_as_float(bu[j].x & 0xffff0000u), __uint_as_float(bu[j].y << 16), __uint_as_float(bu[j].y & 0xffff0000u)};
                    bs = bs * bd[j] + uf; }
                bc += 4;
            }
            WG_BAR();
        }
#undef AT_LOAD
#undef AT_STORE
        const float inv = 1.0f / lrun; float ss = 0.f;
#pragma unroll
        for (int db = 0; db < 4; ++db)
#pragma unroll
            for (int r = 0; r < 16; ++r) { o[db][r] *= inv; ss += o[db][r] * o[db][r]; }
        ss = xsum32(ss);
        if (hi == 0) F.SSQ[tokq * AH + h] = ss;
        bf16_t* op = F.MIX + tokq * DM + h * DH;
#pragma unroll
        for (int db = 0; db < 4; ++db) {
            v2u pc[4];
#pragma unroll
            for (int rg = 0; rg < 4; ++rg) { const int d0 = 32 * db + 8 * rg + 4 * hi; const f32x4 g = *(const f32x4*)(F.aog + h * DH + d0);
                pc[rg].x = pk2(o[db][4 * rg + 0] * g.x, o[db][4 * rg + 1] * g.y); pc[rg].y = pk2(o[db][4 * rg + 2] * g.z, o[db][4 * rg + 3] * g.w); }
            store_pair16(op + 32 * db, pc[0], pc[1], hi); store_pair16(op + 32 * db + 16, pc[2], pc[3], hi);
        }
    }
    for (; bc < NCH; bc += 4) {
        v2u bu[4]; float bd[4];
#pragma unroll
        for (int j = 0; j < 4; ++j) { bu[j] = *(const v2u*)(bU + (size_t)(bc + j) * BUS); bd[j] = bD[(bc + j) * BDS]; }
#pragma unroll
        for (int j = 0; j < 4; ++j) { v2u wv; wv.x = pk2(bs.x, bs.y); wv.y = pk2(bs.z, bs.w); *(v2u*)(bU + (size_t)(bc + j) * BUS) = wv;
            const f32x4 uf = (f32x4){__uint_as_float(bu[j].x << 16), __uint_as_float(bu[j].x & 0xffff0000u), __uint_as_float(bu[j].y << 16), __uint_as_float(bu[j].y & 0xffff0000u)};
            bs = bs * bd[j] + uf; }
    }
    WG_BAR();
}

__device__ __forceinline__ float sigm(float x) { return __builtin_amdgcn_rcpf(1.0f + __builtin_amdgcn_exp2f(-1.4426950408889634f * x)); }
template <bool C> struct HRaw { bf16_t f[16]; bf16_t q[C ? 16 : 1]; v4u val[2]; v4u sst[C ? 4 : 1]; v2u g[C ? 4 : 1]; f32x4 sq[C ? 2 : 1]; float lbk; };
template <bool C> __device__ __forceinline__ void hraw_load(HRaw<C>& r, Frame& F, int item) {
    const int h = item & 7, blk = item >> 3; const size_t tok0 = (size_t)blk * CHUNK;
    const int k = F.tid & 127, tq = F.tid >> 7;
    r.lbk = F.LB[h * DK + k];
    const bf16_t* fp = F.R + (tok0 + 16 * tq) * RW + GW + h * DK + k;
#pragma unroll
    for (int j = 0; j < 16; ++j) { r.f[j] = fp[(size_t)j * RW]; if (C) r.q[j] = fp[(size_t)j * RW - GW]; }
#pragma unroll
    for (int i = 0; i < 2; ++i) { const int ii = F.tid + i * NTHR, t = ii >> 4, ch = ii & 15; r.val[i] = *(const v4u*)(F.R + (tok0 + t) * RW + 2 * GW + h * DV + ch * 8); }
    if (C) { const bf16_t* U = ((const bf16_t*)F.out + (size_t)32 * 1024 * 1024);
#pragma unroll
        for (int i = 0; i < 4; ++i) { const int ii = F.tid + i * NTHR, kk = ii >> 4, ch = ii & 15; r.sst[i] = *(const v4u*)(U + (size_t)item * (DK * DV) + kk * DV + ch * 8); }
        const int w = F.wave, vb = w & 3, tb = w >> 2, r32 = F.lane & 31, hi = F.lane >> 5; const size_t tok = tok0 + 32 * tb + r32;
#pragma unroll
        for (int rg = 0; rg < 4; ++rg) r.g[rg] = *(const v2u*)(F.R + tok * RW + 3 * GW + h * DV + 32 * vb + 8 * rg + 4 * hi);
        r.sq[0] = *(const f32x4*)(F.SSQ + tok * AH); r.sq[1] = *(const f32x4*)(F.SSQ + tok * AH + 4); }
}
template <bool C>
__device__ __forceinline__ float hgrn_prep(Frame& F, const HRaw<C>& r, LAS unsigned char* kd, int kpitch, LAS unsigned char* qd, int qpitch, LAS float* seg) {
    const int k = F.tid & 127, tq = F.tid >> 7;
    const float lbk = r.lbk;
    float fv[16], cp[16], run = 1.f;
#pragma unroll
    for (int j = 0; j < 16; ++j) { const float f = lbk + (1.0f - lbk) * sigm(bf2f(r.f[j])); fv[j] = f; run *= f; cp[j] = run; }
    seg[tq * 128 + k] = run;
    __syncthreads();
    float off = 1.f, tot = 1.f;
#pragma unroll
    for (int q = 0; q < 4; ++q) { const float sv = seg[q * 128 + k]; tot *= sv; off *= (q < tq) ? sv : 1.f; }
#pragma unroll
    for (int j = 0; j < 16; ++j) { const float e = off * cp[j]; const int t = 16 * tq + j;
        { const float kv = (1.0f - fv[j]) * __builtin_amdgcn_rcpf(e); *(LAS bf16_t*)(kd + t * kpitch + k * 2) = (bf16_t)pk2(kv, kv); }
        if (C) { const float qr = bf2f(r.q[j]); const float qv = qr * sigm(qr) * e; *(LAS bf16_t*)(qd + t * qpitch + k * 2) = (bf16_t)pk2(qv, qv); } }
    return tot;
}
constexpr int HA_KD = 0, HA_VAL = 20480, HA_SEG = 40960, HA_DEC = 43008;
__device__ __forceinline__ void hgrn_a_phase(Frame& F) {
    const int lane = F.lane, w = F.wave, r32 = lane & 31, hi = lane >> 5;
    LAS unsigned char* kd = F.lds + HA_KD; LAS unsigned char* val = F.lds + HA_VAL; LAS float* seg = (LAS float*)(F.lds + HA_SEG); LAS float* dec = (LAS float*)(F.lds + HA_DEC);
    const int trq = (lane & 15) >> 2, trc = 16 * ((lane >> 4) & 1) + 4 * (lane & 3);
    bf16_t* U = ((bf16_t*)F.out + (size_t)32 * 1024 * 1024);
    const int nblk = (BATCH * NCH - F.vcu + F.G - 1) / F.G, nit = nblk * 8;
    HRaw<false> nxt;
    if (nit > 0) hraw_load<false>(nxt, F, F.vcu * 8);
    for (int idx = 0; idx < nit; ++idx) {
        const int item = (F.vcu + (idx >> 3) * F.G) * 8 + (idx & 7);
        const HRaw<false> cur = nxt;
        if (idx + 1 < nit) hraw_load<false>(nxt, F, (F.vcu + ((idx + 1) >> 3) * F.G) * 8 + ((idx + 1) & 7));
        const float tot = hgrn_prep<false>(F, cur, kd, 320, kd, 320, seg);
        if (F.tid < 128) { dec[F.tid] = tot; F.DEC[(size_t)item * DK + F.tid] = tot; }
#pragma unroll
        for (int i = 0; i < 2; ++i) { const int ii = F.tid + i * NTHR, t = ii >> 4, ch = ii & 15; *(LAS v4u*)(val + t * 320 + ch * 16) = cur.val[i]; }
        __syncthreads();
        const int kb = w >> 1;
        const float dk = dec[32 * kb + r32];
#pragma unroll
        for (int vi = 0; vi < 2; ++vi) { const int vb = 2 * (w & 1) + vi;
            f32x16 acc;
#pragma unroll
            for (int r = 0; r < 16; ++r) acc[r] = 0.f;
#pragma unroll
            for (int s4 = 0; s4 < 4; ++s4) {
                const bf16x8 a = tr2(kd + (16 * s4 + 8 * hi + trq) * 320 + (32 * kb + trc) * 2, 4 * 320);
                const bf16x8 bb = tr2(val + (16 * s4 + 8 * hi + trq) * 320 + (32 * vb + trc) * 2, 4 * 320);
                acc = MFMA32(bb, a, acc);
            }
            bf16_t* up = U + (size_t)item * (DK * DV) + (size_t)(32 * kb + r32) * DV + 32 * vb;
            v2u pc[4];
#pragma unroll
            for (int rg = 0; rg < 4; ++rg) { pc[rg].x = pk2(acc[4 * rg + 0] * dk, acc[4 * rg + 1] * dk); pc[rg].y = pk2(acc[4 * rg + 2] * dk, acc[4 * rg + 3] * dk); }
            store_pair16(up, pc[0], pc[1], hi); store_pair16(up + 16, pc[2], pc[3], hi);
        }
        __syncthreads();
    }
}
__device__ __forceinline__ void hgrn_b_phase(Frame& F, int first) {
    bf16_t* U = ((bf16_t*)F.out + (size_t)32 * 1024 * 1024);
    for (int g = first + F.vcu * NTHR + F.tid; g < BATCH * GH * DK * (DV / 4); g += F.G * NTHR) {
        const int bh = g >> 12, k = (g >> 5) & 127, v4 = g & 31, b = bh >> 3, h = bh & 7;
        f32x4 s = (f32x4){0.f, 0.f, 0.f, 0.f};
        for (int c0 = 0; c0 < NCH; c0 += 16) {
            v2u u[16]; float d[16];
#pragma unroll
            for (int j = 0; j < 16; ++j) { const size_t item = (size_t)(b * NCH + c0 + j) * 8 + h; u[j] = *(const v2u*)(U + item * (DK * DV) + k * DV + v4 * 4); d[j] = F.DEC[item * DK + k]; }
#pragma unroll
            for (int j = 0; j < 16; ++j) { const size_t item = (size_t)(b * NCH + c0 + j) * 8 + h;
                v2u wv; wv.x = pk2(s.x, s.y); wv.y = pk2(s.z, s.w); *(v2u*)(U + item * (DK * DV) + k * DV + v4 * 4) = wv;
                const f32x4 uf = (f32x4){__uint_as_float(u[j].x << 16), __uint_as_float(u[j].x & 0xffff0000u), __uint_as_float(u[j].y << 16), __uint_as_float(u[j].y & 0xffff0000u)};
                s = s * d[j] + uf; }
        }
    }
}
constexpr int HC_QD = 0, HC_KD = 17408, HC_VAL = 34816, HC_S = 55296, HC_SEG = 96256, HC_RED = 98304;
__device__ __forceinline__ void hgrn_c_phase(Frame& F) {
    const int lane = F.lane, w = F.wave, r32 = lane & 31, hi = lane >> 5;
    LAS unsigned char* qd = F.lds + HC_QD; LAS unsigned char* kd = F.lds + HC_KD; LAS unsigned char* val = F.lds + HC_VAL; LAS unsigned char* Ss = F.lds + HC_S;
    LAS float* seg = (LAS float*)(F.lds + HC_SEG); LAS float* red = (LAS float*)(F.lds + HC_RED);
    const int trq = (lane & 15) >> 2, trc = 16 * ((lane >> 4) & 1) + 4 * (lane & 3);
    const int vb = w & 3, tb = w >> 2;
    f32x4 gn[4];
#pragma unroll
    for (int rg = 0; rg < 4; ++rg) gn[rg] = *(const f32x4*)(F.gng + 32 * vb + 8 * rg + 4 * hi);
    const int nblk = (BATCH * NCH - F.vcu + F.G - 1) / F.G, nit = nblk * 8;
    HRaw<true> nxt;
    if (nit > 0) hraw_load<true>(nxt, F, F.vcu * 8);
    for (int idx = 0; idx < nit; ++idx) {
        {
            const int item = (F.vcu + (idx >> 3) * F.G) * 8 + (idx & 7); const int h = item & 7; const size_t tok0 = (size_t)(item >> 3) * CHUNK;
            const HRaw<true> cur = nxt;
            if (idx + 1 < nit) hraw_load<true>(nxt, F, (F.vcu + ((idx + 1) >> 3) * F.G) * 8 + ((idx + 1) & 7));
            (void)hgrn_prep<true>(F, cur, kd, 272, qd, 272, seg);
#pragma unroll
            for (int i = 0; i < 2; ++i) { const int ii = F.tid + i * NTHR, t = ii >> 4, ch = ii & 15; *(LAS v4u*)(val + t * 320 + ch * 16) = cur.val[i]; }
#pragma unroll
            for (int i = 0; i < 4; ++i) { const int ii = F.tid + i * NTHR, kk = ii >> 4, ch = ii & 15; *(LAS v4u*)(Ss + kk * 320 + ch * 16) = cur.sst[i]; }
            __syncthreads();
            f32x16 acc;
#pragma unroll
            for (int r = 0; r < 16; ++r) acc[r] = 0.f;
            LAS unsigned char* qrow = qd + (32 * tb + r32) * 272 + 16 * hi;
            for (int sb = 0; sb <= tb; ++sb) {
                f32x16 at;
#pragma unroll
                for (int r = 0; r < 16; ++r) at[r] = 0.f;
                LAS unsigned char* krow = kd + (32 * sb + r32) * 272 + 16 * hi;
#pragma unroll
                for (int ks = 0; ks < 8; ++ks) at = MFMA32(*(LAS bf16x8*)(krow + 32 * ks), *(LAS bf16x8*)(qrow + 32 * ks), at);
                if (sb == tb) {
#pragma unroll
                    for (int r = 0; r < 16; ++r) at[r] = (crow(r, hi) > r32) ? 0.f : at[r];
                }
                const bf16x8 pb0 = pack8(at, 0), pb1 = pack8(at, 1);
                const bf16x8 a0 = tr2(val + (32 * sb + 4 * hi + trq) * 320 + (32 * vb + trc) * 2, 8 * 320);
                const bf16x8 a1 = tr2(val + (32 * sb + 16 + 4 * hi + trq) * 320 + (32 * vb + trc) * 2, 8 * 320);
                acc = MFMA32(a0, pb0, acc); acc = MFMA32(a1, pb1, acc);
            }
#pragma unroll
            for (int ks = 0; ks < 8; ++ks) {
                const bf16x8 a = tr2(Ss + (16 * ks + 8 * hi + trq) * 320 + (32 * vb + trc) * 2, 4 * 320);
                acc = MFMA32(a, *(LAS bf16x8*)(qrow + 32 * ks), acc);
            }
            float ss = 0.f;
#pragma unroll
            for (int r = 0; r < 16; ++r) ss += acc[r] * acc[r];
            ss += __shfl_xor(ss, 32);
            if (hi == 0) red[vb * 64 + 32 * tb + r32] = ss;
            __syncthreads();
            const float tot = (red[32 * tb + r32] + red[64 + 32 * tb + r32]) + (red[128 + 32 * tb + r32] + red[192 + 32 * tb + r32]);
            const float rn = rsqrtf(tot * (1.0f / DV) + EPS);
            const size_t tok = tok0 + 32 * tb + r32;
            float rnx;
            { const f32x4 q0 = cur.sq[0], q1 = cur.sq[1]; const float sq = ((q0.x + q0.y) + (q0.z + q0.w)) + ((q1.x + q1.y) + (q1.z + q1.w));
              rnx = rn * sqrtf(sq * (1.0f / AW) + EPS); }
            v2u pc[4];
#pragma unroll
            for (int rg = 0; rg < 4; ++rg) {
                const v2u graw = cur.g[rg]; const f32x4 gg = gn[rg];
                const float g0 = __uint_as_float(graw.x << 16), g1 = __uint_as_float(graw.x & 0xffff0000u), g2 = __uint_as_float(graw.y << 16), g3 = __uint_as_float(graw.y & 0xffff0000u);
                pc[rg].x = pk2(acc[4 * rg + 0] * rnx * gg.x * g0 * sigm(g0), acc[4 * rg + 1] * rnx * gg.y * g1 * sigm(g1));
                pc[rg].y = pk2(acc[4 * rg + 2] * rnx * gg.z * g2 * sigm(g2), acc[4 * rg + 3] * rnx * gg.w * g3 * sigm(g3)); }
            { bf16_t* mp = F.MIX + tok * DM + AW + h * DV + 32 * vb; store_pair16(mp, pc[0], pc[1], hi); store_pair16(mp + 16, pc[2], pc[3], hi); }
            __syncthreads();
        }
    }
}

__global__ void __launch_bounds__(NTHR, 2) mk_fwd(Args args) {
    extern __shared__ __attribute__((aligned(16))) unsigned char lds[];
    Frame F;
    F.lds = (LAS unsigned char*)lds;
    F.tid = threadIdx.x; F.lane = F.tid & 63; F.wave = __builtin_amdgcn_readfirstlane(F.tid >> 6);
    F.G = gridDim.x; { const int bx = blockIdx.x; F.vcu = (F.G % 8 == 0) ? (bx % 8) * (F.G / 8) + bx / 8 : bx; }
    unsigned char* ws = args.ws;
    F.x = args.in[0]; F.g1 = args.in[1]; F.w_in = args.in[2]; F.relb = args.in[3]; F.lower = args.in[4]; F.gng = args.in[5]; F.aog = args.in[6]; F.w_out = args.in[7];
    F.g2 = args.in[8]; F.w_gate = args.in[9]; F.w_up = args.in[10]; F.w_down = args.in[11]; F.gf = args.in[12]; F.out = args.out;
    F.LB = (float*)(ws + WS_LB); F.PART1 = (float*)(ws + WS_PART1); F.DEC = (float*)(ws + WS_DEC); F.SSQ = (float*)(ws + WS_SSQ);
    F.WIN = (bf16_t*)(ws + WS_WIN); F.WOUT = (bf16_t*)(ws + WS_WOUT); F.WGU = (bf16_t*)(ws + WS_WGU); F.WDN = (bf16_t*)(ws + WS_WDN);
    F.H = (bf16_t*)(ws + WS_H); F.QKV = (bf16_t*)(ws + WS_QKV); F.R = (bf16_t*)(ws + WS_R); F.FF = (bf16_t*)(ws + WS_FF); F.MIX = (bf16_t*)(ws + WS_MIX);
    volatile LAS unsigned* MISC = (volatile LAS unsigned*)(F.lds + MISC_OFF);
    for (int u = F.tid; u < (LDS_BYTES - RING_BYTES) / 4; u += NTHR) ((LAS unsigned*)(F.lds + RING_BYTES))[u] = 0u;
    __syncthreads();
    const int lo = args.ph_lo, hi = args.ph_hi;
    XcdBarrier bar; bar.bar = (unsigned*)(ws + WS_CTL) + CW_BAR; bar.x = 0; bar.st = nullptr;
    if (hi - lo > 1) bar = xcd_barrier_post((unsigned*)(ws + WS_CTL) + CW_BAR, MISC + 8);
#define IN(k) (lo <= (k) && (k) < hi)
#define SEAM(k) do { if (IN(k) && IN((k) + 1)) xcd_barrier(bar); } while (0)
    if (IN(0)) { p0_prologue(F); SEAM(0); }
    if (IN(1)) {
        pg8::Gemm g{F.H, F.WIN, M, INC, DM}; pg8::StaticOrder S; S.init(M, INC, F.G, (int)blockIdx.x);
        pg8::EpiIn E{F.QKV, F.R};
        pg8::gemm_phase<pg8::EpiIn, pg8::StaticOrder, true, true>(F.lds, g, S, E);
        SEAM(1);
    }
    if (IN(2)) { hgrn_a_phase(F); SEAM(2); }
    if (IN(3)) { attn_phase(F); hgrn_b_phase(F, F.G * NTHR); SEAM(3); }
    if (IN(4)) { hgrn_c_phase(F); SEAM(4); }
    if (IN(5)) {
        pg8::Gemm g{F.MIX, F.WOUT, M, DM, DM}; pg8::StaticOrder S; S.init(M, DM, F.G, (int)blockIdx.x);
        LAS float* tab = (LAS float*)(F.lds + TAB_OFF); const int xp = (int)(blockIdx.x & 7);
        for (int i = F.tid; i < 2048; i += NTHR) { const size_t row = (size_t)xp * 2048 + i; const f32x4 q0 = *(const f32x4*)(F.SSQ + row * AH), q1 = *(const f32x4*)(F.SSQ + row * AH + 4);
            tab[i] = rsqrtf((((q0.x + q0.y) + (q0.z + q0.w)) + ((q1.x + q1.y) + (q1.z + q1.w))) * (1.0f / AW) + EPS); }
        __syncthreads();
        pg8::EpiOut E{F.x, F.H, F.PART1, F.SSQ, tab, xp};
        pg8::gemm_phase<pg8::EpiOut, pg8::StaticOrder, true, true>(F.lds, g, S, E);
        SEAM(5);
    }
    if (IN(6)) {
        pg8::Gemm g{F.H, F.WGU, M, NGU, DM}; pg8::StaticOrder S; S.init(M, NGU, F.G, (int)blockIdx.x);
        LAS float* tab = (LAS float*)(F.lds + TAB_OFF); const int xp = (int)(blockIdx.x & 7);
        for (int i = F.tid; i < 2048; i += NTHR) { const f32x4* pp = (const f32x4*)(F.PART1 + ((size_t)xp * 2048 + i) * 32); float sq = 0.f;
#pragma unroll
            for (int j = 0; j < 8; ++j) { const f32x4 pv = pp[j]; sq += (pv.x + pv.y) + (pv.z + pv.w); }
            tab[i] = rsqrtf(sq * (1.0f / DM) + EPS); }
        __syncthreads();
        pg8::EpiGU E{F.PART1, F.FF, tab, xp};
        pg8::gemm_phase<pg8::EpiGU, pg8::StaticOrder, true, true>(F.lds, g, S, E);
        SEAM(6);
    }
    if (IN(7)) {
        pg8::Gemm g{F.FF, F.WDN, M, DM, DFF}; pg8::StaticOrder S; S.init(M, DM, F.G, (int)blockIdx.x);
        pg8::EpiDown E{F.H, F.MIX};
        pg8::gemm_phase<pg8::EpiDown, pg8::StaticOrder, true, true>(F.lds, g, S, E);
        SEAM(7);
    }
    if (IN(8)) { p8_final(F); }
#undef IN
#undef SEAM
}

static int mk_grid = 0;
static bool mk_setup() {
    if (mk_grid != 0) return mk_grid > 0;
    int dev = 0, cus = 0, per_cu = 0;
    if (hipGetDevice(&dev) != hipSuccess || hipDeviceGetAttribute(&cus, hipDeviceAttributeMultiprocessorCount, dev) != hipSuccess) { mk_grid = -1; return false; }
    if (hipFuncSetAttribute((const void*)mk_fwd, hipFuncAttributeMaxDynamicSharedMemorySize, LDS_BYTES) != hipSuccess) { mk_grid = -1; return false; }
    if (hipOccupancyMaxActiveBlocksPerMultiprocessor(&per_cu, (const void*)mk_fwd, NTHR, LDS_BYTES) != hipSuccess || per_cu < 1) { fprintf(stderr, "mk: occupancy query says %d blocks/CU\n", per_cu); mk_grid = -1; return false; }
    (void)hipGetLastError();
    mk_grid = cus;
    return true;
}
static void mk_launch(const Args& a0, int lo, int hi, int flags, hipStream_t stream) {
    Args a = a0; a.ph_lo = lo; a.ph_hi = hi; a.flags = flags; a.pad = 0;
    void* params[] = {&a};
    hipError_t e = hipLaunchCooperativeKernel((const void*)mk_fwd, dim3(mk_grid), dim3(NTHR), params, LDS_BYTES, stream);
    if (e != hipSuccess) fprintf(stderr, "mk: launch [%d,%d) failed: %s\n", lo, hi, hipGetErrorString(e));
}

extern "C" void kernel_launch(void* const* d_in, const int* in_sizes, int n_in, void* d_out, int out_size, void* d_ws, size_t ws_size, hipStream_t stream) {
    if (n_in != 13 || out_size != M * DM || ws_size < WS_END) { fprintf(stderr, "kernel_launch: unexpected shapes (n_in %d out %d ws %zu)\n", n_in, out_size, ws_size); return; }
    if (!mk_setup()) return;
    float* out = (float*)d_out; unsigned char* ws = (unsigned char*)d_ws;
    (void)hipMemsetAsync(ws + WS_CTL, 0, CTL_ZERO_BYTES, stream);
    Args a{};
    for (int i = 0; i < 13; ++i) a.in[i] = (const float*)d_in[i];
    a.out = out; a.ws = ws;
    mk_launch(a, 0, 9, 0, stream);
}
```

```cpp
#include <hip/hip_runtime.h>
#include <cstdio>
#include <cstdint>

typedef unsigned short bf16_t;

constexpr int BATCH = 4, SEQ = 4096, DM = 2048, M = BATCH * SEQ;
constexpr int CHUNK = 64, NCH = SEQ / CHUNK, NLEFT = 8;
constexpr int AW = 1024, AH = 8, DH = 128, RELSZ = 257;
constexpr int GW = 1024, GH = 8, DK = 128, DV = 128;
constexpr int INC = 7168, DFF = 5632, NGU = 2 * DFF;
constexpr int QKVW = 3 * AW, RW = 4 * GW;
constexpr float EPS = 1e-6f;

constexpr size_t MiB = 1u << 20;
constexpr size_t WS_CTL = 0;
constexpr size_t WS_LB = 1 * MiB;
constexpr size_t WS_PART1 = 2 * MiB;
constexpr size_t WS_DEC = 4 * MiB;
constexpr size_t WS_SSQ = 5 * MiB;
constexpr size_t WS_QKV = 58 * MiB;
constexpr size_t WS_R = 154 * MiB;
constexpr size_t WS_FF = 58 * MiB;
constexpr size_t WS_MIX = 282 * MiB;
constexpr size_t WS_WDN = 346 * MiB;
constexpr size_t WS_WGU = 368 * MiB;
constexpr size_t WS_WOUT = 412 * MiB;
constexpr size_t WS_WIN = 420 * MiB;
constexpr size_t WS_H = 448 * MiB;
constexpr size_t WS_END = 512 * MiB;

__device__ __forceinline__ float bf2f(bf16_t v) { return __uint_as_float(((unsigned)v) << 16); }
__device__ __forceinline__ bf16_t f2bf(float f) { unsigned u = __float_as_uint(f); return (bf16_t)((u + 0x7fffu + ((u >> 16) & 1u)) >> 16); }

namespace pg8 {
#define PG8_LAS __attribute__((address_space(3)))
typedef short bf16x8 __attribute__((ext_vector_type(8)));
typedef float f32x4 __attribute__((ext_vector_type(4)));
typedef unsigned u32x4 __attribute__((ext_vector_type(4)));
typedef unsigned u32x2 __attribute__((ext_vector_type(2)));
constexpr int BM = 256, BK = 64, HALF = 128, HTB = HALF * BK * 2, STAGE_BYTES = 8 * HTB, NXCD = 8, WGM = 8;

__host__ __device__ __forceinline__ int lds_byte(int r, int c) { const int st = (r >> 4) * 2 + (c >> 5), rr = r & 15, cc = c & 31, ob = rr * 64 + cc * 2; return st * 1024 + (ob ^ (((ob >> 9) & 1) << 5)); }
__host__ __device__ __forceinline__ void stage_rc(int b, int& R, int& C) { const int st = b / 1024, sb = b % 1024, swz = sb ^ (((sb >> 9) & 1) << 5); R = (st >> 1) * 16 + swz / 64; C = (st & 1) * 32 + (swz % 64) / 2; }
__host__ __device__ __forceinline__ int perm32(int rho) { const int n = rho >> 4, i = rho & 15; return 8 * (i >> 2) + 4 * n + (i & 3); }

struct Unit { int pm, pn; };
struct Gemm { const bf16_t* A; const bf16_t* Bt; int M, N, K; };

struct StaticOrder {
    int nM, nN, nwg, G, c;
    __host__ __device__ void init(int M_, int N_, int G_, int c_) { nM = M_ / BM; nN = N_ / BM; nwg = nM * nN; G = G_; c = c_; }
    __host__ __device__ bool next(int i, Unit& u) const {
        const long L = (long)i * G + c; if (L >= nwg) return false;
        int wgid = (int)L; { const int q = nwg / NXCD, r = nwg % NXCD, xcd = wgid % NXCD, off = wgid / NXCD; wgid = (xcd < r ? xcd * (q + 1) : r * (q + 1) + (xcd - r) * q) + off; }
        const int nig = WGM * nN, gid = wgid / nig, fm = gid * WGM, gsz = (nM - fm) < WGM ? (nM - fm) : WGM;
        u.pm = fm + ((wgid % nig) % gsz); u.pn = (wgid % nig) / gsz; return true;
    }
};
typedef float f32x2_t __attribute__((ext_vector_type(2))); typedef __bf16 bf16x2_t __attribute__((ext_vector_type(2)));
__device__ __forceinline__ unsigned cvt_pk_bf16(float lo, float hi) { const f32x2_t v = {lo, hi}; const bf16x2_t b = __builtin_convertvector(v, bf16x2_t); return __builtin_bit_cast(unsigned, b); }

__device__ __forceinline__ void store16_wt(void* p, u32x4 v) { asm volatile("global_store_dwordx4 %0, %1, off sc1\n\ts_nop 1" :: "v"(p), "v"(v) : "memory"); }
struct EpiIn {
    static constexpr bool PERM = true;
    bf16_t* qkv; bf16_t* r;
    __device__ __forceinline__ void operator()(const f32x4 (&acc)[2][2][4][2], const Unit& u, int wr, int wc, int fr, int fq) const {
        const int row0 = u.pm * BM + wr * 64 + fr; int colt = u.pn * BM; bf16_t* base = qkv; int ldc = QKVW;
        const float sc = (colt < AW) ? 0.12751743104794074f : 1.0f;
        if (colt >= QKVW) { base = r; colt -= QKVW; ldc = RW; }
        const int col0 = colt + wc * 32 + 8 * fq;
#pragma unroll
        for (int ai = 0; ai < 2; ++ai)
#pragma unroll
            for (int m = 0; m < 4; ++m) { bf16_t* rowp = base + (size_t)(row0 + ai * HALF + m * 16) * ldc + col0;
#pragma unroll
                for (int bj = 0; bj < 2; ++bj) { const f32x4 v0 = acc[ai][bj][m][0] * sc, v1 = acc[ai][bj][m][1] * sc;
                    u32x4 w; w.x = cvt_pk_bf16(v0[0], v0[1]); w.y = cvt_pk_bf16(v0[2], v0[3]); w.z = cvt_pk_bf16(v1[0], v1[1]); w.w = cvt_pk_bf16(v1[2], v1[3]);
                    store16_wt(rowp + bj * HALF, w); } }
    }
};
struct EpiOut {
    static constexpr bool PERM = true;
    const float* x; bf16_t* x1b; float* part; const float* ssq; const PG8_LAS float* tab; int xp;
    __device__ __forceinline__ void operator()(const f32x4 (&acc)[2][2][4][2], const Unit& u, int wr, int wc, int fr, int fq) const {
        const int col0 = u.pn * BM + wc * 32 + 8 * fq;
        const bool intab = (u.pm >> 3) == xp;
#pragma unroll
        for (int ai = 0; ai < 2; ++ai) {
            f32x4 xv[4][2][2];
#pragma unroll
            for (int m = 0; m < 4; ++m) { const size_t off = (size_t)(u.pm * BM + ai * HALF + wr * 64 + m * 16 + fr) * DM + col0;
#pragma unroll
                for (int bj = 0; bj < 2; ++bj)
#pragma unroll
                    for (int n = 0; n < 2; ++n) xv[m][bj][n] = __builtin_nontemporal_load((const f32x4*)(x + off + bj * HALF + n * 4)); }
#pragma unroll
            for (int m = 0; m < 4; ++m) { const int rl = ai * HALF + wr * 64 + m * 16 + fr, r = u.pm * BM + rl; const size_t off = (size_t)r * DM + col0; float s = 0.f;
                float sa;
                if (intab) sa = tab[(u.pm & 7) * BM + rl];
                else { const f32x4 q0 = *(const f32x4*)(ssq + (size_t)r * AH), q1 = *(const f32x4*)(ssq + (size_t)r * AH + 4); sa = rsqrtf((((q0[0] + q0[1]) + (q0[2] + q0[3])) + ((q1[0] + q1[1]) + (q1[2] + q1[3]))) * (1.0f / AW) + EPS); }
#pragma unroll
                for (int bj = 0; bj < 2; ++bj) { const f32x4 y0 = xv[m][bj][0] + acc[ai][bj][m][0] * sa, y1 = xv[m][bj][1] + acc[ai][bj][m][1] * sa;
                    u32x4 w; w.x = cvt_pk_bf16(y0[0], y0[1]); w.y = cvt_pk_bf16(y0[2], y0[3]); w.z = cvt_pk_bf16(y1[0], y1[1]); w.w = cvt_pk_bf16(y1[2], y1[3]);
                    store16_wt(x1b + off + bj * HALF, w);
                    s += ((y0[0] * y0[0] + y0[1] * y0[1]) + (y0[2] * y0[2] + y0[3] * y0[3])) + ((y1[0] * y1[0] + y1[1] * y1[1]) + (y1[2] * y1[2] + y1[3] * y1[3])); }
                s += __shfl_xor(s, 16); s += __shfl_xor(s, 32);
                if (fq == 0) part[(size_t)r * 32 + u.pn * 4 + wc] = s; }
            asm volatile("" ::: "memory");
        }
    }
};
struct EpiGU {
    static constexpr bool PERM = true;
    const float* part; bf16_t* ff; const PG8_LAS float* tab; int xp;
    __device__ __forceinline__ void operator()(const f32x4 (&acc)[2][2][4][2], const Unit& u, int wr, int wc, int fr, int fq) const {
        const int col0 = u.pn * HALF + wc * 32 + 8 * fq;
        const bool intab = (u.pm >> 3) == xp;
#pragma unroll
        for (int ai = 0; ai < 2; ++ai)
#pragma unroll
            for (int m = 0; m < 4; ++m) { const int rl = ai * HALF + wr * 64 + m * 16 + fr, r = u.pm * BM + rl;
                float rs;
                if (intab) rs = tab[(u.pm & 7) * BM + rl];
                else { const f32x4* pp = (const f32x4*)(part + (size_t)r * 32); float sq = 0.f;
#pragma unroll
                    for (int i = 0; i < 8; ++i) { const f32x4 p = pp[i]; sq += (p[0] + p[1]) + (p[2] + p[3]); }
                    rs = rsqrtf(sq * (1.0f / DM) + EPS); }
                float o[8];
                const float c1 = -1.4426950408889634f * rs, c2 = rs * rs;
#pragma unroll
                for (int n = 0; n < 2; ++n)
#pragma unroll
                    for (int e = 0; e < 4; ++e) { const float g = acc[ai][0][m][n][e], up = acc[ai][1][m][n][e];
                        o[n * 4 + e] = (g * up) * (c2 * __builtin_amdgcn_rcpf(1.0f + __builtin_amdgcn_exp2f(c1 * g))); }
                u32x4 w; w.x = cvt_pk_bf16(o[0], o[1]); w.y = cvt_pk_bf16(o[2], o[3]); w.z = cvt_pk_bf16(o[4], o[5]); w.w = cvt_pk_bf16(o[6], o[7]);
                store16_wt(ff + (size_t)r * DFF + col0, w); }
    }
};
struct EpiDown {
    static constexpr bool PERM = true;
    const bf16_t* x1b; bf16_t* x2b;
    __device__ __forceinline__ void operator()(const f32x4 (&acc)[2][2][4][2], const Unit& u, int wr, int wc, int fr, int fq) const {
        const int col0 = u.pn * BM + wc * 32 + 8 * fq;
#pragma unroll
        for (int ai = 0; ai < 2; ++ai) {
            u32x4 xb[4][2];
#pragma unroll
            for (int m = 0; m < 4; ++m) { const size_t off = (size_t)(u.pm * BM + ai * HALF + wr * 64 + m * 16 + fr) * DM + col0;
#pragma unroll
                for (int bj = 0; bj < 2; ++bj) xb[m][bj] = __builtin_nontemporal_load((const u32x4*)(x1b + off + bj * HALF)); }
#pragma unroll
            for (int m = 0; m < 4; ++m) { const size_t off = (size_t)(u.pm * BM + ai * HALF + wr * 64 + m * 16 + fr) * DM + col0;
#pragma unroll
                for (int bj = 0; bj < 2; ++bj) { const u32x4 b = xb[m][bj]; const f32x4 a0 = acc[ai][bj][m][0], a1 = acc[ai][bj][m][1];
                    u32x4 w;
                    w.x = cvt_pk_bf16(__uint_as_float(b.x << 16) + a0[0], __uint_as_float(b.x & 0xffff0000u) + a0[1]);
                    w.y = cvt_pk_bf16(__uint_as_float(b.y << 16) + a0[2], __uint_as_float(b.y & 0xffff0000u) + a0[3]);
                    w.z = cvt_pk_bf16(__uint_as_float(b.z << 16) + a1[0], __uint_as_float(b.z & 0xffff0000u) + a1[1]);
                    w.w = cvt_pk_bf16(__uint_as_float(b.w << 16) + a1[2], __uint_as_float(b.w & 0xffff0000u) + a1[3]);
                    store16_wt(x2b + off + bj * HALF, w); } }
            asm volatile("" ::: "memory");
        }
    }
};

template <class Epi, class Sched, bool ALIGN_EPI = false, bool SP2 = false>
__device__ __forceinline__ void gemm_phase(PG8_LAS unsigned char* lds, const Gemm g, const Sched& S, const Epi& E) {
    const int tid = threadIdx.x, wid = __builtin_amdgcn_readfirstlane(tid >> 6), lane = tid & 63, wr = wid >> 2, wc = wid & 3, fr = lane & 15, fq = lane >> 4;
    const int K = g.K, nt = K / BK;
    unsigned voffA[2], voffB[2];
#pragma unroll
    for (int i = 0; i < 2; ++i) { int R, C; stage_rc(tid * 16 + i * 8192, R, C); const int Rb = Epi::PERM ? ((R & ~31) + perm32(R & 31)) : R;
        voffA[i] = (unsigned)(R * K + C) * 2u; voffB[i] = (unsigned)(Rb * K + C) * 2u; }
    const size_t kstep = (size_t)(BK * 2);
    const size_t hstep = (size_t)HALF * K * 2;
    const size_t tstep = 2 * hstep;
    const unsigned ldsw = (unsigned)wid * 1024u;
    const int aoff = lds_byte(wr * 64 + fr, fq * 8), boff = lds_byte(wc * 32 + fr, fq * 8);
#define PG8_SA(b, h) (((b) * 2 + (h)) * HTB)
#define PG8_SB(b, h) ((4 + (b) * 2 + (h)) * HTB)
#define PG8_STAGE(bufoff, gbase, voff) do { _Pragma("unroll") for (int _i = 0; _i < 2; ++_i) \
        __builtin_amdgcn_global_load_lds((const unsigned*)((const char*)(gbase) + (voff)[_i]), (PG8_LAS unsigned*)(lds + (bufoff) + ldsw + _i * 8192), 16, 0, 0); } while (0)
#define PG8_LDA(dst, b, h) do { _Pragma("unroll") for (int m = 0; m < 4; ++m) _Pragma("unroll") for (int k = 0; k < 2; ++k) dst[m][k] = *(const PG8_LAS bf16x8*)(lds + PG8_SA(b, h) + aoff + m * 2048 + k * 1024); } while (0)
#define PG8_LDB(dst, b, h) do { _Pragma("unroll") for (int n = 0; n < 2; ++n) _Pragma("unroll") for (int k = 0; k < 2; ++k) dst[n][k] = *(const PG8_LAS bf16x8*)(lds + PG8_SB(b, h) + boff + n * 2048 + k * 1024); } while (0)
#define PG8_MMA(ai, bj, At, Bt) do { __builtin_amdgcn_s_setprio(1); _Pragma("unroll") for (int m = 0; m < 4; ++m) _Pragma("unroll") for (int n = 0; n < 2; ++n) _Pragma("unroll") for (int k = 0; k < 2; ++k) \
        acc[ai][bj][m][n] = __builtin_amdgcn_mfma_f32_16x16x32_bf16(Bt[n][k], At[m][k], acc[ai][bj][m][n], 0, 0, 0); __builtin_amdgcn_s_setprio(0); } while (0)
#define PG8_WAIT_V(n) asm volatile("s_waitcnt vmcnt(" #n ")" ::: "memory")
#define PG8_WAIT_L(n) asm volatile("s_waitcnt lgkmcnt(" #n ")" ::: "memory")
#define PG8_BAR __builtin_amdgcn_s_barrier()
#define PG8_SCHED __builtin_amdgcn_sched_barrier(0)
    Unit cur, nxt; int ui = 0;
    if (!S.next(0, cur)) return;
    f32x4 acc[2][2][4][2];
#pragma unroll
    for (int a = 0; a < 2; ++a)
#pragma unroll
        for (int b = 0; b < 2; ++b)
#pragma unroll
            for (int m = 0; m < 4; ++m)
#pragma unroll
                for (int n = 0; n < 2; ++n) acc[a][b][m][n] = (f32x4){0.f, 0.f, 0.f, 0.f};
    bf16x8 At[4][2], B0[2][2], B1[2][2];
    const char* cA = (const char*)g.A + (size_t)cur.pm * tstep; const char* cB = (const char*)g.Bt + (size_t)cur.pn * tstep;
    if constexpr (SP2) {
        PG8_STAGE(PG8_SB(0, 0), cB, voffB); PG8_STAGE(PG8_SB(0, 1), cB + hstep, voffB); PG8_STAGE(PG8_SA(0, 0), cA, voffA); PG8_STAGE(PG8_SA(0, 1), cA + hstep, voffA);
        if (wr == 1) PG8_BAR;
        PG8_WAIT_V(2); PG8_BAR;
        PG8_STAGE(PG8_SB(1, 0), cB + kstep, voffB); PG8_STAGE(PG8_SA(1, 0), cA + kstep, voffA); PG8_STAGE(PG8_SB(1, 1), cB + hstep + kstep, voffB);
        PG8_WAIT_V(6); PG8_BAR;
    } else {
        PG8_STAGE(PG8_SB(0, 0), cB, voffB); PG8_STAGE(PG8_SA(0, 0), cA, voffA); PG8_STAGE(PG8_SB(0, 1), cB + hstep, voffB); PG8_STAGE(PG8_SA(0, 1), cA + hstep, voffA);
        if (wr == 1) PG8_BAR;
        PG8_WAIT_V(4); PG8_BAR;
        PG8_STAGE(PG8_SB(1, 0), cB + kstep, voffB); PG8_STAGE(PG8_SA(1, 0), cA + kstep, voffA); PG8_STAGE(PG8_SB(1, 1), cB + hstep + kstep, voffB);
        PG8_WAIT_V(6); PG8_BAR;
    }
    for (;;) {
        const bool has_next = S.next(ui + 1, nxt);
        const char* nA = has_next ? (const char*)g.A + (size_t)nxt.pm * tstep : cA; const char* nB = has_next ? (const char*)g.Bt + (size_t)nxt.pn * tstep : cB;
        for (int t = 0; t < nt; t += 2) {
            const bool last = (t == nt - 2);
            const char* a1 = cA + (size_t)(t + 1) * kstep;
            const char* a2 = last ? nA : cA + (size_t)(t + 2) * kstep; const char* b2 = last ? nB : cB + (size_t)(t + 2) * kstep;
            const char* a3 = a2 + kstep; const char* b3 = b2 + kstep;
            if constexpr (SP2) {
            PG8_LDB(B0, 0, 0); PG8_LDB(B1, 0, 1); PG8_SCHED; PG8_LDA(At, 0, 0); PG8_STAGE(PG8_SA(1, 1), a1 + hstep, voffA);
            PG8_WAIT_V(8); PG8_WAIT_L(0); PG8_BAR; PG8_MMA(0, 0, At, B0); PG8_MMA(0, 1, At, B1); PG8_BAR; PG8_SCHED;
            PG8_LDA(At, 0, 1); PG8_STAGE(PG8_SB(0, 0), b2, voffB); PG8_STAGE(PG8_SB(0, 1), b2 + hstep, voffB); PG8_STAGE(PG8_SA(0, 0), a2, voffA);
            PG8_WAIT_V(8); PG8_WAIT_L(0); PG8_BAR; PG8_MMA(1, 0, At, B0); PG8_MMA(1, 1, At, B1); PG8_BAR; PG8_SCHED;
            PG8_LDB(B0, 1, 0); PG8_LDB(B1, 1, 1); PG8_SCHED; PG8_LDA(At, 1, 0); PG8_STAGE(PG8_SA(0, 1), a2 + hstep, voffA);
            PG8_WAIT_V(8); PG8_WAIT_L(0); PG8_BAR; PG8_MMA(0, 0, At, B0); PG8_MMA(0, 1, At, B1); PG8_BAR; PG8_SCHED;
            PG8_LDA(At, 1, 1); PG8_STAGE(PG8_SB(1, 0), b3, voffB); PG8_STAGE(PG8_SB(1, 1), b3 + hstep, voffB); PG8_STAGE(PG8_SA(1, 0), a3, voffA);
            PG8_WAIT_V(8); PG8_WAIT_L(0); PG8_BAR; PG8_MMA(1, 0, At, B0); PG8_MMA(1, 1, At, B1); PG8_BAR; PG8_SCHED;
            } else {
            PG8_LDB(B0, 0, 0); PG8_SCHED; PG8_LDA(At, 0, 0); PG8_STAGE(PG8_SA(1, 1), a1 + hstep, voffA);
            PG8_WAIT_L(8); PG8_BAR; PG8_WAIT_L(0); PG8_MMA(0, 0, At, B0); PG8_BAR; PG8_SCHED;
            PG8_LDB(B1, 0, 1); PG8_STAGE(PG8_SB(0, 0), b2, voffB);
            PG8_BAR; PG8_WAIT_L(0); PG8_MMA(0, 1, At, B1); PG8_BAR;
            PG8_LDA(At, 0, 1); PG8_STAGE(PG8_SA(0, 0), a2, voffA);
            PG8_BAR; PG8_WAIT_L(0); PG8_MMA(1, 0, At, B0); PG8_BAR; PG8_SCHED;
            PG8_STAGE(PG8_SB(0, 1), b2 + hstep, voffB);
            PG8_WAIT_V(6); PG8_BAR; PG8_MMA(1, 1, At, B1); PG8_BAR;
            PG8_LDB(B0, 1, 0); PG8_SCHED; PG8_LDA(At, 1, 0); PG8_STAGE(PG8_SA(0, 1), a2 + hstep, voffA);
            PG8_WAIT_L(8); PG8_BAR; PG8_WAIT_L(0); PG8_MMA(0, 0, At, B0); PG8_BAR; PG8_SCHED;
            PG8_LDB(B1, 1, 1); PG8_STAGE(PG8_SB(1, 0), b3, voffB);
            PG8_BAR; PG8_WAIT_L(0); PG8_MMA(0, 1, At, B1); PG8_BAR;
            PG8_LDA(At, 1, 1); PG8_STAGE(PG8_SA(1, 0), a3, voffA);
            PG8_BAR; PG8_WAIT_L(0); PG8_MMA(1, 0, At, B0); PG8_BAR; PG8_SCHED;
            PG8_STAGE(PG8_SB(1, 1), b3 + hstep, voffB);
            PG8_WAIT_V(6); PG8_BAR; PG8_MMA(1, 1, At, B1); PG8_BAR;
            }
        }
        if constexpr (ALIGN_EPI) { if (wr == 0) PG8_BAR; }
        E(acc, cur, wr, wc, fr, fq);
        if (!has_next) break;
#pragma unroll
        for (int a = 0; a < 2; ++a)
#pragma unroll
            for (int b = 0; b < 2; ++b)
#pragma unroll
                for (int m = 0; m < 4; ++m)
#pragma unroll
                    for (int n = 0; n < 2; ++n) acc[a][b][m][n] = (f32x4){0.f, 0.f, 0.f, 0.f};
        cur = nxt; cA = nA; cB = nB; ++ui;
        if constexpr (ALIGN_EPI) { if (wr == 1) PG8_BAR; }
    }
    PG8_WAIT_V(0);
    if constexpr (!ALIGN_EPI) { if (wr == 0) PG8_BAR; }
    PG8_BAR;
#undef PG8_SA
#undef PG8_SB
#undef PG8_STAGE
#undef PG8_LDA
#undef PG8_LDB
#undef PG8_MMA
#undef PG8_WAIT_V
#undef PG8_WAIT_L
#undef PG8_BAR
#undef PG8_SCHED
}
}

#define GAS __attribute__((address_space(1)))
#define LAS __attribute__((address_space(3)))
typedef unsigned v4u __attribute__((ext_vector_type(4)));
typedef unsigned v2u __attribute__((ext_vector_type(2)));
typedef float f32x4 __attribute__((ext_vector_type(4)));
typedef float f32x16 __attribute__((ext_vector_type(16)));
typedef short bf16x8 __attribute__((ext_vector_type(8)));
typedef short s16x4 __attribute__((ext_vector_type(4)));
typedef GAS unsigned gu32;
#define RLX_AGENT __ATOMIC_RELAXED, __HIP_MEMORY_SCOPE_AGENT
#define LDS_WAIT() asm volatile("s_waitcnt lgkmcnt(0)" ::: "memory")

constexpr int NWAVES = 8, NTHR = 512;
constexpr int RING_BYTES = 131072, MISC_OFF = RING_BYTES + 320, LDS_BYTES = 147456;
constexpr int CW_BAR = 4096;
constexpr int TAB_OFF = RING_BYTES + 1024;
constexpr size_t CTL_ZERO_BYTES = 64 * 1024;

#define XB_TMO      128
#define XB_XCNT(j)  (256  + 64 * (j))
#define XB_XSUB(j)  (1280 + 64 * (j))
#define XB_XGEN(j)  (2304 + 64 * (j))
#define XB_TOP      3328
#define XB_TOPGEN   3392
#define XCD_BAR_WORDS 3456
#define XB_SPIN_CAP (1u << 22)
__device__ __forceinline__ unsigned xb_ld(unsigned* p)              { return __hip_atomic_load(p, __ATOMIC_RELAXED, __HIP_MEMORY_SCOPE_AGENT); }
__device__ __forceinline__ unsigned xb_add(unsigned* p, unsigned v) { return __hip_atomic_fetch_add(p, v, __ATOMIC_RELAXED, __HIP_MEMORY_SCOPE_AGENT); }
__device__ __forceinline__ unsigned xb_xcc_id() { return (unsigned)__builtin_amdgcn_s_getreg((3 << 11) | 20) & 0xFu; }
#define XB_SPIN(cond, bar) do { unsigned _sp = 0; while (cond) { __builtin_amdgcn_s_sleep(1); \
    if ((++_sp & 255u) == 0u) { if (xb_ld(&(bar)[XB_TMO])) break; if (_sp > XB_SPIN_CAP) { atomicAdd(&(bar)[XB_TMO], 1u); break; } } } } while (0)
struct XcdBarrier { unsigned* bar; unsigned x; volatile LAS unsigned* st; };
__device__ __forceinline__ XcdBarrier xcd_barrier_post(unsigned* bar, volatile LAS unsigned* st) {
    XcdBarrier b; b.bar = bar; b.x = xb_xcc_id(); b.st = st;
    if (threadIdx.x == 0) (void)xb_add(&bar[XB_XCNT(b.x)], 1u);
    return b;
}
__device__ __forceinline__ void xcd_barrier_complete(unsigned* bar, unsigned x, unsigned& nloc, unsigned& nx) {
    const unsigned G = gridDim.x * gridDim.y * gridDim.z;
    unsigned sum, cnt, mine, sp = 0u;
    for (;;) {
        sum = 0u; cnt = 0u; mine = 0u;
#pragma unroll
        for (unsigned j = 0; j < 16; ++j) { const unsigned c = xb_ld(&bar[XB_XCNT(j)]); sum += c; cnt += (c > 0u) ? 1u : 0u; mine = (j == x) ? c : mine; }
        if (sum == G) break;
        __builtin_amdgcn_s_sleep(1);
        if ((++sp & 255u) == 0u) { if (xb_ld(&bar[XB_TMO])) break; if (sp > XB_SPIN_CAP) { atomicAdd(&bar[XB_TMO], 1u); break; } }
    }
    nloc = mine > 0u ? mine : 1u; nx = cnt > 0u ? cnt : 1u;
}
__device__ __forceinline__ void xcd_barrier(const XcdBarrier& b) {
    asm volatile("s_waitcnt vmcnt(0)" ::: "memory");
    __syncthreads();
    if (threadIdx.x == 0) {
        unsigned* bar = b.bar;
        __builtin_amdgcn_s_waitcnt(0);
        unsigned nloc = b.st[0], nx = b.st[1];
        if (nloc == 0u) { xcd_barrier_complete(bar, b.x, nloc, nx); b.st[0] = nloc; b.st[1] = nx; }
        const unsigned old = xb_add(&bar[XB_XSUB(b.x)], 1u);
        const unsigned gen = old / nloc;
        if (old + 1u == (gen + 1u) * nloc) {
            __builtin_amdgcn_fence(__ATOMIC_RELEASE, "agent");
            asm volatile("s_waitcnt vmcnt(0)" ::: "memory");
            const unsigned og = xb_add(&bar[XB_TOP], 1u);
            const unsigned tg = og / nx;
            if (og + 1u == (tg + 1u) * nx) xb_add(&bar[XB_TOPGEN], 1u);
            else XB_SPIN(xb_ld(&bar[XB_TOPGEN]) == tg, bar);
            __builtin_amdgcn_fence(__ATOMIC_ACQUIRE, "agent");
            xb_add(&bar[XB_XGEN(b.x)], 1u);
            asm volatile("s_waitcnt vmcnt(0)" ::: "memory");
        } else {
            XB_SPIN(xb_ld(&bar[XB_XGEN(b.x)]) == gen, bar);
            __builtin_amdgcn_fence(__ATOMIC_ACQUIRE, "agent");
            asm volatile("s_waitcnt vmcnt(0)" ::: "memory");
        }
    }
    __syncthreads();
}

struct Args { const float* in[13]; float* out; unsigned char* ws; int ph_lo, ph_hi, flags, pad; };

struct Frame {
    LAS unsigned char* lds; int tid, lane, wave, vcu, G;
    const float *x, *g1, *w_in, *relb, *lower, *gng, *aog, *w_out, *g2, *w_gate, *w_up, *w_down, *gf;
    float* out; float *LB, *PART1, *DEC, *SSQ;
    bf16_t *WIN, *WOUT, *WGU, *WDN, *H, *QKV, *R, *FF, *MIX;
};

__device__ __forceinline__ float wave_sum(float v) {
#pragma unroll
    for (int o = 1; o < 64; o <<= 1) v += __shfl_xor(v, o);
    return v;
}
__device__ __forceinline__ unsigned pk2(float lo, float hi) { return pg8::cvt_pk_bf16(lo, hi); }
__device__ __forceinline__ int crow(int r, int hi) { return (r & 3) + 8 * (r >> 2) + 4 * hi; }
__device__ __forceinline__ void store_pair16(bf16_t* base16, v2u a, v2u b, int hi) {
    const auto rx = __builtin_amdgcn_permlane32_swap(a.x, b.x, false, false); const auto ry = __builtin_amdgcn_permlane32_swap(a.y, b.y, false, false);
    pg8::u32x4 w; w.x = rx[0]; w.y = ry[0]; w.z = rx[1]; w.w = ry[1];
    *(pg8::u32x4*)(base16 + (hi ? 8 : 0)) = w;
}

template <int MODE>
__device__ __forceinline__ void p0_transpose_item(const float* W, int K, int N, bf16_t* WT, int which, const float* ks, LAS float* scr, int item, int lane) {
    const int nblk = N / 32, kb = item / nblk, nb = item % nblk, k0 = 64 * kb, n0 = 32 * nb;
    f32x4 v[8];
    const float* wp = W + (size_t)(k0 + (lane >> 3)) * N + n0 + 4 * (lane & 7);
#pragma unroll
    for (int i = 0; i < 8; ++i) v[i] = __builtin_nontemporal_load((const GAS f32x4*)(wp + (size_t)(8 * i) * N));
#pragma unroll
    for (int i = 0; i < 8; ++i) { const int kk = 8 * i + (lane >> 3); f32x4 x = v[i]; if (MODE == 1) x = x * ks[k0 + kk];
        LAS float* d = scr + kk * 33 + 4 * (lane & 7); d[0] = x.x; d[1] = x.y; d[2] = x.z; d[3] = x.w; }
    LDS_WAIT(); asm volatile("" ::: "memory");
    const int c = lane & 7;
#pragma unroll
    for (int j = 0; j < 4; ++j) { const int nl = (lane >> 3) + 8 * j; const LAS float* s = scr + (8 * c) * 33 + nl; const int n = n0 + nl;
        const int row = (MODE == 0) ? n : (256 * (n >> 7) + 128 * which + (n & 127));
        v4u o; o.x = pk2(s[0 * 33], s[1 * 33]); o.y = pk2(s[2 * 33], s[3 * 33]); o.z = pk2(s[4 * 33], s[5 * 33]); o.w = pk2(s[6 * 33], s[7 * 33]);
        *(GAS v4u*)(WT + (size_t)row * K + k0 + 8 * c) = o; }
    LDS_WAIT(); asm volatile("" ::: "memory");
}
__device__ __forceinline__ void rms_row_to_bf16(const float* xrow, const float* gain, bf16_t* orow, int lane) {
    const GAS f32x4* xr = (const GAS f32x4*)xrow + lane; const GAS f32x4* gr = (const GAS f32x4*)gain + lane;
    f32x4 v[8]; float s = 0.f;
#pragma unroll
    for (int j = 0; j < 8; ++j) { v[j] = __builtin_nontemporal_load(xr + 64 * j); s += (v[j].x * v[j].x + v[j].y * v[j].y) + (v[j].z * v[j].z + v[j].w * v[j].w); }
    const float r = rsqrtf(wave_sum(s) * (1.f / DM) + EPS);
    GAS v2u* o8 = (GAS v2u*)orow + lane;
#pragma unroll
    for (int j = 0; j < 8; ++j) { const f32x4 g = gr[64 * j]; v2u w; w.x = pk2(v[j].x * r * g.x, v[j].y * r * g.y); w.y = pk2(v[j].z * r * g.z, v[j].w * r * g.w); o8[64 * j] = w; }
}
__device__ __forceinline__ void p0_prologue(Frame& F) {
    LAS float* scr = (LAS float*)(F.lds + F.wave * 16384);
    const int gw = F.vcu * NWAVES + F.wave, NGW = F.G * NWAVES;
    constexpr int I_IN = (DM / 64) * (INC / 32), I_OUT = (DM / 64) * (DM / 32), I_G = (DM / 64) * (DFF / 32), I_DN = (DFF / 64) * (DM / 32);
    constexpr int NITEMS = I_IN + I_OUT + 2 * I_G + I_DN;
    for (int it = gw; it < NITEMS; it += NGW) {
        int r = it;
        if (r < I_IN) { p0_transpose_item<0>(F.w_in, DM, INC, F.WIN, 0, nullptr, scr, r, F.lane); continue; } r -= I_IN;
        if (r < I_OUT) { p0_transpose_item<0>(F.w_out, DM, DM, F.WOUT, 0, nullptr, scr, r, F.lane); continue; } r -= I_OUT;
        if (r < I_G) { p0_transpose_item<1>(F.w_gate, DM, DFF, F.WGU, 0, F.g2, scr, r, F.lane); continue; } r -= I_G;
        if (r < I_G) { p0_transpose_item<1>(F.w_up, DM, DFF, F.WGU, 1, F.g2, scr, r, F.lane); continue; } r -= I_G;
        p0_transpose_item<0>(F.w_down, DFF, DM, F.WDN, 0, nullptr, scr, r, F.lane);
    }
    for (int m = gw; m < M; m += NGW) rms_row_to_bf16(F.x + (size_t)m * DM, F.g1, F.H + (size_t)m * DM, F.lane);
    const int gt = F.vcu * NTHR + F.tid;
    if (gt < GW) { const float a = F.lower[gt], b = F.lower[GW + gt], mx = fmaxf(a, b); const float ea = __expf(a - mx), eb = __expf(b - mx); F.LB[gt] = ea / (ea + eb); }
}
__device__ __forceinline__ void p8_final(Frame& F) {
    const int gw = F.vcu * NWAVES + F.wave, NGW = F.G * NWAVES;
    const GAS f32x4* gr = (const GAS f32x4*)F.gf + 2 * F.lane;
    for (int m = gw; m < M; m += 2 * NGW) {
        const int m1 = m + NGW; const bool two = m1 < M;
        const GAS v4u* xr0 = (const GAS v4u*)(F.MIX + (size_t)m * DM) + F.lane; const GAS v4u* xr1 = (const GAS v4u*)(F.MIX + (size_t)(two ? m1 : m) * DM) + F.lane;
        v4u b0[4], b1[4];
#pragma unroll
        for (int j = 0; j < 4; ++j) { b0[j] = __builtin_nontemporal_load(xr0 + 64 * j); b1[j] = __builtin_nontemporal_load(xr1 + 64 * j); }
#pragma unroll
        for (int rr = 0; rr < 2; ++rr) {
            if (rr == 1 && !two) break;
            float v[4][8]; float s = 0.f;
#pragma unroll
            for (int j = 0; j < 4; ++j) { const v4u bb = rr ? b1[j] : b0[j]; const unsigned w[4] = {bb.x, bb.y, bb.z, bb.w};
#pragma unroll
                for (int e = 0; e < 4; ++e) { v[j][2 * e] = __uint_as_float(w[e] << 16); v[j][2 * e + 1] = __uint_as_float(w[e] & 0xffff0000u); s += v[j][2 * e] * v[j][2 * e] + v[j][2 * e + 1] * v[j][2 * e + 1]; } }
            const float r = rsqrtf(wave_sum(s) * (1.f / DM) + EPS);
            GAS f32x4* orow = (GAS f32x4*)(F.out + (size_t)(rr ? m1 : m) * DM) + 2 * F.lane;
#pragma unroll
            for (int j = 0; j < 4; ++j) { const f32x4 g0 = gr[128 * j], g1 = gr[128 * j + 1];
                __builtin_nontemporal_store((f32x4){v[j][0] * r * g0.x, v[j][1] * r * g0.y, v[j][2] * r * g0.z, v[j][3] * r * g0.w}, orow + 128 * j);
                __builtin_nontemporal_store((f32x4){v[j][4] * r * g1.x, v[j][5] * r * g1.y, v[j][6] * r * g1.z, v[j][7] * r * g1.w}, orow + 128 * j + 1); }
        }
    }
}

typedef short v4i16_t __attribute__((ext_vector_type(4)));
__device__ __forceinline__ s16x4 vtr(LAS unsigned char* p) { return __builtin_bit_cast(s16x4, __builtin_amdgcn_ds_read_tr16_b64_v4i16((LAS v4i16_t*)p)); }
__device__ __forceinline__ bf16x8 tr2(LAS unsigned char* p, int second_off) { const s16x4 a = vtr(p), b = vtr(p + second_off); return (bf16x8){a[0], a[1], a[2], a[3], b[0], b[1], b[2], b[3]}; }
#define MFMA32(a, b, c) __builtin_amdgcn_mfma_f32_32x32x16_bf16((a), (b), (c), 0, 0, 0)
__device__ __forceinline__ bf16x8 pack8(const f32x16& p, int s2) {
    v4u w; w.x = pk2(p[8 * s2 + 0], p[8 * s2 + 1]); w.y = pk2(p[8 * s2 + 2], p[8 * s2 + 3]); w.z = pk2(p[8 * s2 + 4], p[8 * s2 + 5]); w.w = pk2(p[8 * s2 + 6], p[8 * s2 + 7]);
    return __builtin_bit_cast(bf16x8, w);
}
__device__ __forceinline__ float xmax32(float v) { const auto rr = __builtin_amdgcn_permlane32_swap(__float_as_uint(v), __float_as_uint(v), false, false); return fmaxf(__uint_as_float(rr[0]), __uint_as_float(rr[1])); }
__device__ __forceinline__ float xsum32(float v) { const auto rr = __builtin_amdgcn_permlane32_swap(__float_as_uint(v), __float_as_uint(v), false, false); return __uint_as_float(rr[0]) + __uint_as_float(rr[1]); }
#define WG_BAR() do { asm volatile("s_waitcnt lgkmcnt(0)" ::: "memory"); __builtin_amdgcn_s_barrier(); asm volatile("" ::: "memory"); } while (0)
constexpr int AT_KP = 272, AT_VP = 320, AT_KT = 64 * AT_KP, AT_VT = 64 * AT_VP, AT_BUF = AT_KT + AT_VT, AT_BIAS = 2 * AT_BUF, AT_NT = 12;
__device__ __forceinline__ void attn_phase(Frame& F) {
    const int lane = F.lane, w = F.wave, r32 = lane & 31, hi = lane >> 5, cwl = w >> 1, qb = w & 1;
    LAS float* bw = (LAS float*)(F.lds + AT_BIAS);
    constexpr float LOG2E = 1.4426950408889634f;
    const int trq = (lane & 15) >> 2, trc = 16 * ((lane >> 4) & 1) + 4 * (lane & 3);
    const int srow = F.tid >> 4, sch = F.tid & 15;
    const int iq = 32 * qb + r32;
    const int bg = F.vcu * NTHR + F.tid; const bool bhas = bg < BATCH * GH * DK * (DV / 4);
    bf16_t* bU = ((bf16_t*)F.out + (size_t)32 * 1024 * 1024); const float* bD = F.DEC; int bc = bhas ? 0 : NCH; f32x4 bs = (f32x4){0.f, 0.f, 0.f, 0.f};
    if (bhas) { const int bh = bg >> 12, k = (bg >> 5) & 127, v4 = bg & 31, b_ = bh >> 3, h_ = bh & 7; bU += ((size_t)(b_ * NCH) * 8 + h_) * (DK * DV) + k * DV + v4 * 4; bD += ((size_t)(b_ * NCH) * 8 + h_) * DK + k; }
    constexpr size_t BUS = (size_t)8 * DK * DV; constexpr int BDS = 8 * DK;
    for (int item = F.vcu; item < BATCH * AH * (NCH / 4); item += F.G) {
        const int cg = item & 15, h = (item >> 4) & 7, b = item >> 7;
        { const float bfar_ = F.relb[h * RELSZ + 256];
          for (int t = F.tid; t < 640; t += NTHR) { int d = NLEFT * CHUNK + 63 - t; d = d > 128 ? 128 : d; bw[t] = (F.relb[h * RELSZ + d + 128] - bfar_) * LOG2E; } }
        const size_t tokq = (size_t)b * SEQ + (size_t)(4 * cg + cwl) * CHUNK + iq;
        bf16x8 qf[8];
        { const bf16_t* qp = F.QKV + tokq * QKVW + h * DH + 8 * hi;
#pragma unroll
          for (int ks = 0; ks < 8; ++ks) qf[ks] = *(const bf16x8*)(qp + 16 * ks); }
        const int T0 = (cg >= 2) ? 0 : (NLEFT - 4 * cg);
        const bf16_t* sbase = F.QKV + ((long)b * SEQ + (long)(4 * cg - NLEFT) * CHUNK + srow) * QKVW + AW + h * DH + 8 * sch;
        LAS unsigned char* kdst = F.lds + srow * AT_KP + sch * 16; LAS unsigned char* vdst = F.lds + AT_KT + srow * AT_VP + sch * 16;
        v4u kr0, kr1, vr0, vr1;
#define AT_LOAD(T_) do { const bf16_t* sp_ = sbase + (size_t)(64 * (T_)) * QKVW; kr0 = *(const v4u*)sp_; kr1 = *(const v4u*)(sp_ + (size_t)32 * QKVW); vr0 = *(const v4u*)(sp_ + AW); vr1 = *(const v4u*)(sp_ + (size_t)32 * QKVW + AW); } while (0)
#define AT_STORE(bufoff) do { *(LAS v4u*)(kdst + (bufoff)) = kr0; *(LAS v4u*)(kdst + (bufoff) + 32 * AT_KP) = kr1; *(LAS v4u*)(vdst + (bufoff)) = vr0; *(LAS v4u*)(vdst + (bufoff) + 32 * AT_VP) = vr1; } while (0)
        AT_LOAD(T0); AT_STORE(0); AT_LOAD(T0 + 1);
        f32x16 o[4];
#pragma unroll
        for (int db = 0; db < 4; ++db)
#pragma unroll
            for (int r = 0; r < 16; ++r) o[db][r] = 0.f;
        float mrun = 0.f, lrun = 0.f; bool first = true;
        f32x16 negm;
#pragma unroll
        for (int r = 0; r < 16; ++r) negm[r] = 0.f;
        WG_BAR();
        for (int T = T0; T < AT_NT; ++T) {
            const int cur = (T - T0) & 1;
            if (T + 1 < AT_NT) AT_STORE((cur ^ 1) * AT_BUF);
            if (T + 2 < AT_NT) AT_LOAD(T + 2);
            v2u bu[4]; float bd[4]; const bool bact = bc < NCH;
            if (bact) {
#pragma unroll
                for (int j = 0; j < 4; ++j) { bu[j] = *(const v2u*)(bU + (size_t)(bc + j) * BUS); bd[j] = bD[(bc + j) * BDS]; }
            }
            const int kc = T - cwl;
            if (kc >= 0 && kc <= NLEFT) {
                LAS unsigned char* kb = F.lds + cur * AT_BUF + r32 * AT_KP + 16 * hi;
                LAS unsigned char* vtr0 = F.lds + cur * AT_BUF + AT_KT + (4 * hi + trq) * AT_VP + trc * 2;
                f32x16 s0 = negm, s1 = negm;
                __builtin_amdgcn_s_setprio(1);
#pragma unroll
                for (int ks = 0; ks < 8; ++ks) { s0 = MFMA32(*(LAS bf16x8*)(kb + 32 * ks), qf[ks], s0); s1 = MFMA32(*(LAS bf16x8*)(kb + 32 * AT_KP + 32 * ks), qf[ks], s1); }
                __builtin_amdgcn_s_setprio(0);
                if (kc >= 6) {
                    const LAS float* bp = bw + (64 * kc + 63 - iq + 4 * hi);
#pragma unroll
                    for (int r = 0; r < 16; ++r) { s0[r] += bp[(r & 3) + 8 * (r >> 2)]; s1[r] += bp[32 + (r & 3) + 8 * (r >> 2)]; }
                }
                float mx = fmaxf(s0[0], s1[0]);
#pragma unroll
                for (int r = 1; r < 16; ++r) mx = fmaxf(mx, fmaxf(s0[r], s1[r]));
                mx = xmax32(mx);
                if (first || __builtin_amdgcn_ballot_w64(mx > 0.f) != 0ull) {
                    const float dl = first ? mx : fmaxf(mx, 0.f);
                    mrun += dl;
#pragma unroll
                    for (int r = 0; r < 16; ++r) { s0[r] -= dl; s1[r] -= dl; negm[r] = -mrun; }
                    if (!first) { const float al = __builtin_amdgcn_exp2f(-dl); lrun *= al;
#pragma unroll
                        for (int db = 0; db < 4; ++db)
#pragma unroll
                            for (int r = 0; r < 16; ++r) o[db][r] *= al; }
                    first = false;
                }
                float rs0 = 0.f, rs1 = 0.f;
#pragma unroll
                for (int r = 0; r < 16; ++r) { s0[r] = __builtin_amdgcn_exp2f(s0[r]); s1[r] = __builtin_amdgcn_exp2f(s1[r]); rs0 += s0[r]; rs1 += s1[r]; }
                lrun += xsum32(rs0 + rs1);
                const bf16x8 pb0 = pack8(s0, 0), pb1 = pack8(s0, 1), pb2 = pack8(s1, 0), pb3 = pack8(s1, 1);
#pragma unroll
                for (int db = 0; db < 4; ++db) {
                    const bf16x8 a0 = tr2(vtr0 + db * 64, 8 * AT_VP), a1 = tr2(vtr0 + 16 * AT_VP + db * 64, 8 * AT_VP);
                    const bf16x8 a2 = tr2(vtr0 + 32 * AT_VP + db * 64, 8 * AT_VP), a3 = tr2(vtr0 + 48 * AT_VP + db * 64, 8 * AT_VP);
                    __builtin_amdgcn_s_setprio(1);
                    o[db] = MFMA32(a0, pb0, o[db]); o[db] = MFMA32(a1, pb1, o[db]); o[db] = MFMA32(a2, pb2, o[db]); o[db] = MFMA32(a3, pb3, o[db]);
                    __builtin_amdgcn_s_setprio(0);
                }
            }
            if (bact) {
#pragma unroll
                for (int j = 0; j < 4; ++j) { v2u wv; wv.x = pk2(bs.x, bs.y); wv.y = pk2(bs.z, bs.w); *(v2u*)(bU + (size_t)(bc + j) * BUS) = wv;
                    const f32x4 uf = (f32x4){__uint_as_float(bu[j].x << 16), __uint_as_float(bu[j].x & 0xffff0000u), __uint_as_float(bu[j].y << 16), __uint_as_float(bu[j].y & 0xffff0000u)};
                    bs = bs * bd[j] + uf; }
                bc += 4;
            }
            WG_BAR();
        }
#undef AT_LOAD
#undef AT_STORE
        const float inv = 1.0f / lrun; float ss = 0.f;
#pragma unroll
        for (int db = 0; db < 4; ++db)
#pragma unroll
            for (int r = 0; r < 16; ++r) { o[db][r] *= inv; ss += o[db][r] * o[db][r]; }
        ss = xsum32(ss);
        if (hi == 0) F.SSQ[tokq * AH + h] = ss;
        bf16_t* op = F.MIX + tokq * DM + h * DH;
#pragma unroll
        for (int db = 0; db < 4; ++db) {
            v2u pc[4];
#pragma unroll
            for (int rg = 0; rg < 4; ++rg) { const int d0 = 32 * db + 8 * rg + 4 * hi; const f32x4 g = *(const f32x4*)(F.aog + h * DH + d0);
                pc[rg].x = pk2(o[db][4 * rg + 0] * g.x, o[db][4 * rg + 1] * g.y); pc[rg].y = pk2(o[db][4 * rg + 2] * g.z, o[db][4 * rg + 3] * g.w); }
            store_pair16(op + 32 * db, pc[0], pc[1], hi); store_pair16(op + 32 * db + 16, pc[2], pc[3], hi);
        }
    }
    for (; bc < NCH; bc += 4) {
        v2u bu[4]; float bd[4];
#pragma unroll
        for (int j = 0; j < 4; ++j) { bu[j] = *(const v2u*)(bU + (size_t)(bc + j) * BUS); bd[j] = bD[(bc + j) * BDS]; }
#pragma unroll
        for (int j = 0; j < 4; ++j) { v2u wv; wv.x = pk2(bs.x, bs.y); wv.y = pk2(bs.z, bs.w); *(v2u*)(bU + (size_t)(bc + j) * BUS) = wv;
            const f32x4 uf = (f32x4){__uint_as_float(bu[j].x << 16), __uint_as_float(bu[j].x & 0xffff0000u), __uint_as_float(bu[j].y << 16), __uint_as_float(bu[j].y & 0xffff0000u)};
            bs = bs * bd[j] + uf; }
    }
    WG_BAR();
}

__device__ __forceinline__ float sigm(float x) { return __builtin_amdgcn_rcpf(1.0f + __builtin_amdgcn_exp2f(-1.4426950408889634f * x)); }
template <bool C> struct HRaw { bf16_t f[16]; bf16_t q[C ? 16 : 1]; v4u val[2]; v4u sst[C ? 4 : 1]; v2u g[C ? 4 : 1]; f32x4 sq[C ? 2 : 1]; float lbk; };
template <bool C> __device__ __forceinline__ void hraw_load(HRaw<C>& r, Frame& F, int item) {
    const int h = item & 7, blk = item >> 3; const size_t tok0 = (size_t)blk * CHUNK;
    const int k = F.tid & 127, tq = F.tid >> 7;
    r.lbk = F.LB[h * DK + k];
    const bf16_t* fp = F.R + (tok0 + 16 * tq) * RW + GW + h * DK + k;
#pragma unroll
    for (int j = 0; j < 16; ++j) { r.f[j] = fp[(size_t)j * RW]; if (C) r.q[j] = fp[(size_t)j * RW - GW]; }
#pragma unroll
    for (int i = 0; i < 2; ++i) { const int ii = F.tid + i * NTHR, t = ii >> 4, ch = ii & 15; r.val[i] = *(const v4u*)(F.R + (tok0 + t) * RW + 2 * GW + h * DV + ch * 8); }
    if (C) { const bf16_t* U = ((const bf16_t*)F.out + (size_t)32 * 1024 * 1024);
#pragma unroll
        for (int i = 0; i < 4; ++i) { const int ii = F.tid + i * NTHR, kk = ii >> 4, ch = ii & 15; r.sst[i] = *(const v4u*)(U + (size_t)item * (DK * DV) + kk * DV + ch * 8); }
        const int w = F.wave, vb = w & 3, tb = w >> 2, r32 = F.lane & 31, hi = F.lane >> 5; const size_t tok = tok0 + 32 * tb + r32;
#pragma unroll
        for (int rg = 0; rg < 4; ++rg) r.g[rg] = *(const v2u*)(F.R + tok * RW + 3 * GW + h * DV + 32 * vb + 8 * rg + 4 * hi);
        r.sq[0] = *(const f32x4*)(F.SSQ + tok * AH); r.sq[1] = *(const f32x4*)(F.SSQ + tok * AH + 4); }
}
template <bool C>
__device__ __forceinline__ float hgrn_prep(Frame& F, const HRaw<C>& r, LAS unsigned char* kd, int kpitch, LAS unsigned char* qd, int qpitch, LAS float* seg) {
    const int k = F.tid & 127, tq = F.tid >> 7;
    const float lbk = r.lbk;
    float fv[16], cp[16], run = 1.f;
#pragma unroll
    for (int j = 0; j < 16; ++j) { const float f = lbk + (1.0f - lbk) * sigm(bf2f(r.f[j])); fv[j] = f; run *= f; cp[j] = run; }
    seg[tq * 128 + k] = run;
    __syncthreads();
    float off = 1.f, tot = 1.f;
#pragma unroll
    for (int q = 0; q < 4; ++q) { const float sv = seg[q * 128 + k]; tot *= sv; off *= (q < tq) ? sv : 1.f; }
#pragma unroll
    for (int j = 0; j < 16; ++j) { const float e = off * cp[j]; const int t = 16 * tq + j;
        { const float kv = (1.0f - fv[j]) * __builtin_amdgcn_rcpf(e); *(LAS bf16_t*)(kd + t * kpitch + k * 2) = (bf16_t)pk2(kv, kv); }
        if (C) { const float qr = bf2f(r.q[j]); const float qv = qr * sigm(qr) * e; *(LAS bf16_t*)(qd + t * qpitch + k * 2) = (bf16_t)pk2(qv, qv); } }
    return tot;
}
constexpr int HA_KD = 0, HA_VAL = 20480, HA_SEG = 40960, HA_DEC = 43008;
__device__ __forceinline__ void hgrn_a_phase(Frame& F) {
    const int lane = F.lane, w = F.wave, r32 = lane & 31, hi = lane >> 5;
    LAS unsigned char* kd = F.lds + HA_KD; LAS unsigned char* val = F.lds + HA_VAL; LAS float* seg = (LAS float*)(F.lds + HA_SEG); LAS float* dec = (LAS float*)(F.lds + HA_DEC);
    const int trq = (lane & 15) >> 2, trc = 16 * ((lane >> 4) & 1) + 4 * (lane & 3);
    bf16_t* U = ((bf16_t*)F.out + (size_t)32 * 1024 * 1024);
    const int nblk = (BATCH * NCH - F.vcu + F.G - 1) / F.G, nit = nblk * 8;
    HRaw<false> nxt;
    if (nit > 0) hraw_load<false>(nxt, F, F.vcu * 8);
    for (int idx = 0; idx < nit; ++idx) {
        const int item = (F.vcu + (idx >> 3) * F.G) * 8 + (idx & 7);
        const HRaw<false> cur = nxt;
        if (idx + 1 < nit) hraw_load<false>(nxt, F, (F.vcu + ((idx + 1) >> 3) * F.G) * 8 + ((idx + 1) & 7));
        const float tot = hgrn_prep<false>(F, cur, kd, 320, kd, 320, seg);
        if (F.tid < 128) { dec[F.tid] = tot; F.DEC[(size_t)item * DK + F.tid] = tot; }
#pragma unroll
        for (int i = 0; i < 2; ++i) { const int ii = F.tid + i * NTHR, t = ii >> 4, ch = ii & 15; *(LAS v4u*)(val + t * 320 + ch * 16) = cur.val[i]; }
        __syncthreads();
        const int kb = w >> 1;
        const float dk = dec[32 * kb + r32];
#pragma unroll
        for (int vi = 0; vi < 2; ++vi) { const int vb = 2 * (w & 1) + vi;
            f32x16 acc;
#pragma unroll
            for (int r = 0; r < 16; ++r) acc[r] = 0.f;
#pragma unroll
            for (int s4 = 0; s4 < 4; ++s4) {
                const bf16x8 a = tr2(kd + (16 * s4 + 8 * hi + trq) * 320 + (32 * kb + trc) * 2, 4 * 320);
                const bf16x8 bb = tr2(val + (16 * s4 + 8 * hi + trq) * 320 + (32 * vb + trc) * 2, 4 * 320);
                acc = MFMA32(bb, a, acc);
            }
            bf16_t* up = U + (size_t)item * (DK * DV) + (size_t)(32 * kb + r32) * DV + 32 * vb;
            v2u pc[4];
#pragma unroll
            for (int rg = 0; rg < 4; ++rg) { pc[rg].x = pk2(acc[4 * rg + 0] * dk, acc[4 * rg + 1] * dk); pc[rg].y = pk2(acc[4 * rg + 2] * dk, acc[4 * rg + 3] * dk); }
            store_pair16(up, pc[0], pc[1], hi); store_pair16(up + 16, pc[2], pc[3], hi);
        }
        __syncthreads();
    }
}
__device__ __forceinline__ void hgrn_b_phase(Frame& F, int first) {
    bf16_t* U = ((bf16_t*)F.out + (size_t)32 * 1024 * 1024);
    for (int g = first + F.vcu * NTHR + F.tid; g < BATCH * GH * DK * (DV / 4); g += F.G * NTHR) {
        const int bh = g >> 12, k = (g >> 5) & 127, v4 = g & 31, b = bh >> 3, h = bh & 7;
        f32x4 s = (f32x4){0.f, 0.f, 0.f, 0.f};
        for (int c0 = 0; c0 < NCH; c0 += 16) {
            v2u u[16]; float d[16];
#pragma unroll
            for (int j = 0; j < 16; ++j) { const size_t item = (size_t)(b * NCH + c0 + j) * 8 + h; u[j] = *(const v2u*)(U + item * (DK * DV) + k * DV + v4 * 4); d[j] = F.DEC[item * DK + k]; }
#pragma unroll
            for (int j = 0; j < 16; ++j) { const size_t item = (size_t)(b * NCH + c0 + j) * 8 + h;
                v2u wv; wv.x = pk2(s.x, s.y); wv.y = pk2(s.z, s.w); *(v2u*)(U + item * (DK * DV) + k * DV + v4 * 4) = wv;
                const f32x4 uf = (f32x4){__uint_as_float(u[j].x << 16), __uint_as_float(u[j].x & 0xffff0000u), __uint_as_float(u[j].y << 16), __uint_as_float(u[j].y & 0xffff0000u)};
                s = s * d[j] + uf; }
        }
    }
}
constexpr int HC_QD = 0, HC_KD = 17408, HC_VAL = 34816, HC_S = 55296, HC_SEG = 96256, HC_RED = 98304;
__device__ __forceinline__ void hgrn_c_phase(Frame& F) {
    const int lane = F.lane, w = F.wave, r32 = lane & 31, hi = lane >> 5;
    LAS unsigned char* qd = F.lds + HC_QD; LAS unsigned char* kd = F.lds + HC_KD; LAS unsigned char* val = F.lds + HC_VAL; LAS unsigned char* Ss = F.lds + HC_S;
    LAS float* seg = (LAS float*)(F.lds + HC_SEG); LAS float* red = (LAS float*)(F.lds + HC_RED);
    const int trq = (lane & 15) >> 2, trc = 16 * ((lane >> 4) & 1) + 4 * (lane & 3);
    const int vb = w & 3, tb = w >> 2;
    f32x4 gn[4];
#pragma unroll
    for (int rg = 0; rg < 4; ++rg) gn[rg] = *(const f32x4*)(F.gng + 32 * vb + 8 * rg + 4 * hi);
    const int nblk = (BATCH * NCH - F.vcu + F.G - 1) / F.G, nit = nblk * 8;
    HRaw<true> nxt;
    if (nit > 0) hraw_load<true>(nxt, F, F.vcu * 8);
    for (int idx = 0; idx < nit; ++idx) {
        {
            const int item = (F.vcu + (idx >> 3) * F.G) * 8 + (idx & 7); const int h = item & 7; const size_t tok0 = (size_t)(item >> 3) * CHUNK;
            const HRaw<true> cur = nxt;
            if (idx + 1 < nit) hraw_load<true>(nxt, F, (F.vcu + ((idx + 1) >> 3) * F.G) * 8 + ((idx + 1) & 7));
            (void)hgrn_prep<true>(F, cur, kd, 272, qd, 272, seg);
#pragma unroll
            for (int i = 0; i < 2; ++i) { const int ii = F.tid + i * NTHR, t = ii >> 4, ch = ii & 15; *(LAS v4u*)(val + t * 320 + ch * 16) = cur.val[i]; }
#pragma unroll
            for (int i = 0; i < 4; ++i) { const int ii = F.tid + i * NTHR, kk = ii >> 4, ch = ii & 15; *(LAS v4u*)(Ss + kk * 320 + ch * 16) = cur.sst[i]; }
            __syncthreads();
            f32x16 acc;
#pragma unroll
            for (int r = 0; r < 16; ++r) acc[r] = 0.f;
            LAS unsigned char* qrow = qd + (32 * tb + r32) * 272 + 16 * hi;
            for (int sb = 0; sb <= tb; ++sb) {
                f32x16 at;
#pragma unroll
                for (int r = 0; r < 16; ++r) at[r] = 0.f;
                LAS unsigned char* krow = kd + (32 * sb + r32) * 272 + 16 * hi;
#pragma unroll
                for (int ks = 0; ks < 8; ++ks) at = MFMA32(*(LAS bf16x8*)(krow + 32 * ks), *(LAS bf16x8*)(qrow + 32 * ks), at);
                if (sb == tb) {
#pragma unroll
                    for (int r = 0; r < 16; ++r) at[r] = (crow(r, hi) > r32) ? 0.f : at[r];
                }
                const bf16x8 pb0 = pack8(at, 0), pb1 = pack8(at, 1);
                const bf16x8 a0 = tr2(val + (32 * sb + 4 * hi + trq) * 320 + (32 * vb + trc) * 2, 8 * 320);
                const bf16x8 a1 = tr2(val + (32 * sb + 16 + 4 * hi + trq) * 320 + (32 * vb + trc) * 2, 8 * 320);
                acc = MFMA32(a0, pb0, acc); acc = MFMA32(a1, pb1, acc);
            }
#pragma unroll
            for (int ks = 0; ks < 8; ++ks) {
                const bf16x8 a = tr2(Ss + (16 * ks + 8 * hi + trq) * 320 + (32 * vb + trc) * 2, 4 * 320);
                acc = MFMA32(a, *(LAS bf16x8*)(qrow + 32 * ks), acc);
            }
            float ss = 0.f;
#pragma unroll
            for (int r = 0; r < 16; ++r) ss += acc[r] * acc[r];
            ss += __shfl_xor(ss, 32);
            if (hi == 0) red[vb * 64 + 32 * tb + r32] = ss;
            __syncthreads();
            const float tot = (red[32 * tb + r32] + red[64 + 32 * tb + r32]) + (red[128 + 32 * tb + r32] + red[192 + 32 * tb + r32]);
            const float rn = rsqrtf(tot * (1.0f / DV) + EPS);
            const size_t tok = tok0 + 32 * tb + r32;
            float rnx;
            { const f32x4 q0 = cur.sq[0], q1 = cur.sq[1]; const float sq = ((q0.x + q0.y) + (q0.z + q0.w)) + ((q1.x + q1.y) + (q1.z + q1.w));
              rnx = rn * sqrtf(sq * (1.0f / AW) + EPS); }
            v2u pc[4];
#pragma unroll
            for (int rg = 0; rg < 4; ++rg) {
                const v2u graw = cur.g[rg]; const f32x4 gg = gn[rg];
                const float g0 = __uint_as_float(graw.x << 16), g1 = __uint_as_float(graw.x & 0xffff0000u), g2 = __uint_as_float(graw.y << 16), g3 = __uint_as_float(graw.y & 0xffff0000u);
                pc[rg].x = pk2(acc[4 * rg + 0] * rnx * gg.x * g0 * sigm(g0), acc[4 * rg + 1] * rnx * gg.y * g1 * sigm(g1));
                pc[rg].y = pk2(acc[4 * rg + 2] * rnx * gg.z * g2 * sigm(g2), acc[4 * rg + 3] * rnx * gg.w * g3 * sigm(g3)); }
            { bf16_t* mp = F.MIX + tok * DM + AW + h * DV + 32 * vb; store_pair16(mp, pc[0], pc[1], hi); store_pair16(mp + 16, pc[2], pc[3], hi); }
            __syncthreads();
        }
    }
}

__global__ void __launch_bounds__(NTHR, 2) mk_fwd(Args args) {
    extern __shared__ __attribute__((aligned(16))) unsigned char lds[];
    Frame F;
    F.lds = (LAS unsigned char*)lds;
    F.tid = threadIdx.x; F.lane = F.tid & 63; F.wave = __builtin_amdgcn_readfirstlane(F.tid >> 6);
    F.G = gridDim.x; { const int bx = blockIdx.x; F.vcu = (F.G % 8 == 0) ? (bx % 8) * (F.G / 8) + bx / 8 : bx; }
    unsigned char* ws = args.ws;
    F.x = args.in[0]; F.g1 = args.in[1]; F.w_in = args.in[2]; F.relb = args.in[3]; F.lower = args.in[4]; F.gng = args.in[5]; F.aog = args.in[6]; F.w_out = args.in[7];
    F.g2 = args.in[8]; F.w_gate = args.in[9]; F.w_up = args.in[10]; F.w_down = args.in[11]; F.gf = args.in[12]; F.out = args.out;
    F.LB = (float*)(ws + WS_LB); F.PART1 = (float*)(ws + WS_PART1); F.DEC = (float*)(ws + WS_DEC); F.SSQ = (float*)(ws + WS_SSQ);
    F.WIN = (bf16_t*)(ws + WS_WIN); F.WOUT = (bf16_t*)(ws + WS_WOUT); F.WGU = (bf16_t*)(ws + WS_WGU); F.WDN = (bf16_t*)(ws + WS_WDN);
    F.H = (bf16_t*)(ws + WS_H); F.QKV = (bf16_t*)(ws + WS_QKV); F.R = (bf16_t*)(ws + WS_R); F.FF = (bf16_t*)(ws + WS_FF); F.MIX = (bf16_t*)(ws + WS_MIX);
    volatile LAS unsigned* MISC = (volatile LAS unsigned*)(F.lds + MISC_OFF);
    for (int u = F.tid; u < (LDS_BYTES - RING_BYTES) / 4; u += NTHR) ((LAS unsigned*)(F.lds + RING_BYTES))[u] = 0u;
    __syncthreads();
    const int lo = args.ph_lo, hi = args.ph_hi;
    XcdBarrier bar; bar.bar = (unsigned*)(ws + WS_CTL) + CW_BAR; bar.x = 0; bar.st = nullptr;
    if (hi - lo > 1) bar = xcd_barrier_post((unsigned*)(ws + WS_CTL) + CW_BAR, MISC + 8);
#define IN(k) (lo <= (k) && (k) < hi)
#define SEAM(k) do { if (IN(k) && IN((k) + 1)) xcd_barrier(bar); } while (0)
    if (IN(0)) { p0_prologue(F); SEAM(0); }
    if (IN(1)) {
        pg8::Gemm g{F.H, F.WIN, M, INC, DM}; pg8::StaticOrder S; S.init(M, INC, F.G, (int)blockIdx.x);
        pg8::EpiIn E{F.QKV, F.R};
        pg8::gemm_phase<pg8::EpiIn, pg8::StaticOrder, true, true>(F.lds, g, S, E);
        SEAM(1);
    }
    if (IN(2)) { hgrn_a_phase(F); SEAM(2); }
    if (IN(3)) { attn_phase(F); hgrn_b_phase(F, F.G * NTHR); SEAM(3); }
    if (IN(4)) { hgrn_c_phase(F); SEAM(4); }
    if (IN(5)) {
        pg8::Gemm g{F.MIX, F.WOUT, M, DM, DM}; pg8::StaticOrder S; S.init(M, DM, F.G, (int)blockIdx.x);
        LAS float* tab = (LAS float*)(F.lds + TAB_OFF); const int xp = (int)(blockIdx.x & 7);
        for (int i = F.tid; i < 2048; i += NTHR) { const size_t row = (size_t)xp * 2048 + i; const f32x4 q0 = *(const f32x4*)(F.SSQ + row * AH), q1 = *(const f32x4*)(F.SSQ + row * AH + 4);
            tab[i] = rsqrtf((((q0.x + q0.y) + (q0.z + q0.w)) + ((q1.x + q1.y) + (q1.z + q1.w))) * (1.0f / AW) + EPS); }
        __syncthreads();
        pg8::EpiOut E{F.x, F.H, F.PART1, F.SSQ, tab, xp};
        pg8::gemm_phase<pg8::EpiOut, pg8::StaticOrder, true, true>(F.lds, g, S, E);
        SEAM(5);
    }
    if (IN(6)) {
        pg8::Gemm g{F.H, F.WGU, M, NGU, DM}; pg8::StaticOrder S; S.init(M, NGU, F.G, (int)blockIdx.x);
        LAS float* tab = (LAS float*)(F.lds + TAB_OFF); const int xp = (int)(blockIdx.x & 7);
        for (int i = F.tid; i < 2048; i += NTHR) { const f32x4* pp = (const f32x4*)(F.PART1 + ((size_t)xp * 2048 + i) * 32); float sq = 0.f;
#pragma unroll
            for (int j = 0; j < 8; ++j) { const f32x4 pv = pp[j]; sq += (pv.x + pv.y) + (pv.z + pv.w); }
            tab[i] = rsqrtf(sq * (1.0f / DM) + EPS); }
        __syncthreads();
        pg8::EpiGU E{F.PART1, F.FF, tab, xp};
        pg8::gemm_phase<pg8::EpiGU, pg8::StaticOrder, true, true>(F.lds, g, S, E);
        SEAM(6);
    }
    if (IN(7)) {
        pg8::Gemm g{F.FF, F.WDN, M, DM, DFF}; pg8::StaticOrder S; S.init(M, DM, F.G, (int)blockIdx.x);
        pg8::EpiDown E{F.H, F.MIX};
        pg8::gemm_phase<pg8::EpiDown, pg8::StaticOrder, true, true>(F.lds, g, S, E);
        SEAM(7);
    }
    if (IN(8)) { p8_final(F); }
#undef IN
#undef SEAM
}

static int mk_grid = 0;
static bool mk_setup() {
    if (mk_grid != 0) return mk_grid > 0;
    int dev = 0, cus = 0, per_cu = 0;
    if (hipGetDevice(&dev) != hipSuccess || hipDeviceGetAttribute(&cus, hipDeviceAttributeMultiprocessorCount, dev) != hipSuccess) { mk_grid = -1; return false; }
    if (hipFuncSetAttribute((const void*)mk_fwd, hipFuncAttributeMaxDynamicSharedMemorySize, LDS_BYTES) != hipSuccess) { mk_grid = -1; return false; }
    if (hipOccupancyMaxActiveBlocksPerMultiprocessor(&per_cu, (const void*)mk_fwd, NTHR, LDS_BYTES) != hipSuccess || per_cu < 1) { fprintf(stderr, "mk: occupancy query says %d blocks/CU\n", per_cu); mk_grid = -1; return false; }
    (void)hipGetLastError();
    mk_grid = cus;
    return true;
}
static void mk_launch(const Args& a0, int lo, int hi, int flags, hipStream_t stream) {
    Args a = a0; a.ph_lo = lo; a.ph_hi = hi; a.flags = flags; a.pad = 0;
    void* params[] = {&a};
    hipError_t e = hipLaunchCooperativeKernel((const void*)mk_fwd, dim3(mk_grid), dim3(NTHR), params, LDS_BYTES, stream);
    if (e != hipSuccess) fprintf(stderr, "mk: launch [%d,%d) failed: %s\n", lo, hi, hipGetErrorString(e));
}

extern "C" void kernel_launch(void* const* d_in, const int* in_sizes, int n_in, void* d_out, int out_size, void* d_ws, size_t ws_size, hipStream_t stream) {
    if (n_in != 13 || out_size != M * DM || ws_size < WS_END) { fprintf(stderr, "kernel_launch: unexpected shapes (n_in %d out %d ws %zu)\n", n_in, out_size, ws_size); return; }
    if (!mk_setup()) return;
    float* out = (float*)d_out; unsigned char* ws = (unsigned char*)d_ws;
    (void)hipMemsetAsync(ws + WS_CTL, 0, CTL_ZERO_BYTES, stream);
    Args a{};
    for (int i = 0; i < 13; ++i) a.in[i] = (const float*)d_in[i];
    a.out = out; a.ws = ws;
    mk_launch(a, 0, 9, 0, stream);
}
```
